# Optimizing an MI355X kernel written in HIP

```python
import jax, jax.numpy as jnp
from jax import lax
import numpy as np

D_MODEL = 2048
BATCH = 4
SEQ = 2048
DEPTH = 1
DEC_BATCH = 16
DEC_SEQ = 16
PAST_LEN = 2048

CHUNK = 64
N_HEADS = 8
HEAD_DIM = 128
D_ATTN = N_HEADS * HEAD_DIM
D_CONV = 1024
CONV_W = 3
D_FF = 5632
Q_BLOCK = 128
EPS = 1e-6
FFN_SCALE = 0.5
SPLIT_POINTS = (D_CONV, 2 * D_CONV, 3 * D_CONV,
                3 * D_CONV + D_ATTN, 3 * D_CONV + 2 * D_ATTN, 3 * D_CONV + 3 * D_ATTN,
                3 * D_CONV + 3 * D_ATTN + D_MODEL)
D_IN = 3 * D_CONV + 3 * D_ATTN + 2 * D_MODEL

kernel_name = "hybrid_shortconv_stickbreaking_streaming_step"


def _rmsnorm(x, g):
    xf = x.astype(jnp.float32)
    y = xf * lax.rsqrt(jnp.mean(xf * xf, axis=-1, keepdims=True) + EPS)
    return (y * g.astype(jnp.float32)).astype(x.dtype)


def _swiglu(x, w_gate_up, w_down):
    gu = jnp.einsum("btd,df->btf", x, w_gate_up)
    g, u = jnp.split(gu, 2, axis=-1)
    return jnp.einsum("btf,fd->btd", jax.nn.silu(g) * u, w_down)


def _causal_conv(u, hist, w):
    T = u.shape[1]
    full = jnp.concatenate([hist.astype(u.dtype), u], axis=1)
    y = full[:, 0:T] * w[0]
    for i in range(1, CONV_W):
        y = y + full[:, i:i + T] * w[i]
    return y, full[:, -(CONV_W - 1):]


def _stick_breaking_block(q, k, v, q_start):
    Tq, Tk = q.shape[1], k.shape[1]
    z = jnp.einsum("bqhd,bkhd->bhqk", q, k,
                   preferred_element_type=jnp.float32) * (HEAD_DIM ** -0.5)
    t_pos = q_start + jnp.arange(Tq)[:, None]
    s_pos = jnp.arange(Tk)[None, :]
    mask = s_pos < t_pos
    sp = jnp.where(mask, jax.nn.softplus(z), 0.0)
    tail = lax.cumsum(sp, axis=3, reverse=True) - sp
    log_a = jnp.where(mask, jax.nn.log_sigmoid(z) - tail, -jnp.inf)
    a = jnp.exp(log_a)
    return jnp.einsum("bhqk,bkhd->bqhd", a.astype(v.dtype), v)


def _stick_breaking(q, k_all, v_all, q_start):
    T = q.shape[1]
    n_blocks = (T + Q_BLOCK - 1) // Q_BLOCK
    outs = []
    for i in range(n_blocks):
        lo, hi = i * Q_BLOCK, min((i + 1) * Q_BLOCK, T)
        end = q_start + hi
        outs.append(_stick_breaking_block(q[:, lo:hi], k_all[:, :end], v_all[:, :end], q_start + lo))
    return jnp.concatenate(outs, axis=1)


def _layer(x, conv_hist, past_k, past_v, q_start,
           g_ffn1, w_gu1, w_dn1, g_mix, w_in, w_conv, w_conv_out, w_attn_out, w_o,
           g_ffn2, w_gu2, w_dn2):
    B, T, _ = x.shape
    x = x + FFN_SCALE * _swiglu(_rmsnorm(x, g_ffn1), w_gu1, w_dn1)
    h = _rmsnorm(x, g_mix)
    proj = jnp.einsum("btd,de->bte", h, w_in)
    cb, cc, cx, q, k, v, ga, gb = jnp.split(proj, SPLIT_POINTS, axis=-1)
    conv_out, new_hist = _causal_conv(cc * cx, conv_hist, w_conv)
    y_a = jnp.einsum("btc,cd->btd", cb * conv_out, w_conv_out)
    q = q.reshape(B, T, N_HEADS, HEAD_DIM)
    k = k.reshape(B, T, N_HEADS, HEAD_DIM)
    v = v.reshape(B, T, N_HEADS, HEAD_DIM)
    if past_k is None:
        k_all, v_all = k, v
    else:
        k_all = jnp.concatenate([past_k.astype(k.dtype), k], axis=1)
        v_all = jnp.concatenate([past_v.astype(v.dtype), v], axis=1)
    o = _stick_breaking(q, k_all, v_all, q_start).reshape(B, T, D_ATTN)
    y_b = jnp.einsum("bte,ed->btd", o, w_attn_out)
    mixed = jax.nn.sigmoid(ga) * y_a + jax.nn.sigmoid(gb) * y_b
    x = x + jnp.einsum("btd,de->bte", mixed, w_o)
    x = x + FFN_SCALE * _swiglu(_rmsnorm(x, g_ffn2), w_gu2, w_dn2)
    return x, new_hist, k, v


def setup_inputs(seed: int = 0) -> dict:
    key = jax.random.key(seed)
    ks = jax.random.split(key, 20)
    f32 = jnp.float32

    def nrm(k, shape, fan_in):
        return jax.random.normal(k, shape, f32) * (fan_in ** -0.5)

    def gain(k, shape):
        return 1.0 + 0.02 * jax.random.normal(k, shape, f32)

    return {
        "x_prompt": jax.random.normal(ks[0], (BATCH, SEQ, D_MODEL), f32),
        "x_sample": jax.random.normal(ks[1], (DEC_BATCH, DEC_SEQ, D_MODEL), f32),
        "cache_k": jax.random.normal(ks[2], (DEPTH, DEC_BATCH, PAST_LEN, N_HEADS, HEAD_DIM), f32),
        "cache_v": jax.random.normal(ks[3], (DEPTH, DEC_BATCH, PAST_LEN, N_HEADS, HEAD_DIM), f32),
        "state_conv": jax.random.normal(ks[4], (DEPTH, DEC_BATCH, CONV_W - 1, D_CONV), f32),
        "norm_ffn1": gain(ks[5], (DEPTH, D_MODEL)),
        "ffn1_w_gate_up": nrm(ks[6], (DEPTH, D_MODEL, 2 * D_FF), D_MODEL),
        "ffn1_w_down": nrm(ks[7], (DEPTH, D_FF, D_MODEL), D_FF),
        "norm_mix": gain(ks[8], (DEPTH, D_MODEL)),
        "w_in": nrm(ks[9], (DEPTH, D_MODEL, D_IN), D_MODEL),
        "conv_w": nrm(ks[10], (DEPTH, CONV_W, D_CONV), CONV_W),
        "w_conv_out": nrm(ks[11], (DEPTH, D_CONV, D_MODEL), D_CONV),
        "w_attn_out": nrm(ks[12], (DEPTH, D_ATTN, D_MODEL), D_ATTN),
        "w_o": nrm(ks[13], (DEPTH, D_MODEL, D_MODEL), D_MODEL),
        "norm_ffn2": gain(ks[14], (DEPTH, D_MODEL)),
        "ffn2_w_gate_up": nrm(ks[15], (DEPTH, D_MODEL, 2 * D_FF), D_MODEL),
        "ffn2_w_down": nrm(ks[16], (DEPTH, D_FF, D_MODEL), D_FF),
        "norm_final": gain(ks[17], (D_MODEL,)),
    }


def reference(x_prompt, x_sample, cache_k, cache_v, state_conv,
              norm_ffn1, ffn1_w_gate_up, ffn1_w_down, norm_mix, w_in, conv_w,
              w_conv_out, w_attn_out, w_o, norm_ffn2, ffn2_w_gate_up, ffn2_w_down,
              norm_final):
    xp, xs = x_prompt, x_sample
    kp_l, vp_l, cp_l, ks_l, vs_l, cs_l = [], [], [], [], [], []
    for l in range(DEPTH):
        w = (norm_ffn1[l], ffn1_w_gate_up[l], ffn1_w_down[l], norm_mix[l], w_in[l], conv_w[l],
             w_conv_out[l], w_attn_out[l], w_o[l], norm_ffn2[l], ffn2_w_gate_up[l], ffn2_w_down[l])
        hist0 = jnp.zeros((xp.shape[0], CONV_W - 1, D_CONV), xp.dtype)
        xp, c_p, k_p, v_p = _layer(xp, hist0, None, None, 0, *w)
        xs, c_s, k_s, v_s = _layer(xs, state_conv[l], cache_k[l], cache_v[l], PAST_LEN, *w)
        kp_l.append(k_p); vp_l.append(v_p); cp_l.append(c_p)
        ks_l.append(k_s); vs_l.append(v_s); cs_l.append(c_s)
    y_prompt = _rmsnorm(xp, norm_final)
    y_sample = _rmsnorm(xs, norm_final)
    k_prompt = jnp.stack(kp_l, axis=0)
    v_prompt = jnp.stack(vp_l, axis=0)
    conv_prompt = jnp.stack(cp_l, axis=0)
    k_sample = jnp.stack(ks_l, axis=0)
    v_sample = jnp.stack(vs_l, axis=0)
    conv_sample = jnp.stack(cs_l, axis=0)
    return (y_prompt, y_sample, k_prompt, v_prompt, conv_prompt, k_sample, v_sample, conv_sample)
```

```cpp
#include <hip/hip_runtime.h>
#include <cstdio>
#include <cstdint>

#ifndef MK_N_LAUNCHES
#define MK_N_LAUNCHES 1
#endif

constexpr int DM = 2048, NB = 4, SEQ = 2048, DECB = 16, DECS = 16, PAST = 2048, NH = 8, HD = 128, DA = 1024, DC = 1024, DFF = 5632, DIN = 10240;
constexpr int MP = NB * SEQ, MS = DECB * DECS, M = MP + MS;
constexpr float EPS = 1e-6f;
constexpr float QSCALE = 0.08838834764831845f * 1.4426950408889634f;
constexpr float SB_THRESH = 160.f;

constexpr size_t O_Y = 0, O_KP = (size_t)M * DM, O_VP = O_KP + (size_t)MP * DA, O_CP = O_VP + (size_t)MP * DA, O_KS = O_CP + (size_t)NB * 2 * DC,
                 O_VS = O_KS + (size_t)MS * DA, O_CS = O_VS + (size_t)MS * DA, O_END = O_CS + (size_t)DECB * 2 * DC;

constexpr size_t MiB = 1u << 20;
constexpr size_t WS_CTL = 0, CTL_ZERO_BYTES = 1 * MiB;
constexpr size_t WS_WGU1 = 2 * MiB, WS_WDN1 = 46 * MiB, WS_WIN = 68 * MiB, WS_WCO = 108 * MiB, WS_WAO = 112 * MiB, WS_WO = 116 * MiB, WS_WGU2 = 124 * MiB, WS_WDN2 = 168 * MiB;
constexpr size_t WS_XN = 190 * MiB, WS_XG = 223 * MiB, WS_ACT = 256 * MiB, WS_T = WS_ACT  , WS_X = 347 * MiB;
constexpr size_t HALF_MIB = MiB / 2;
constexpr size_t WS_CB = 413 * MiB, WS_U = WS_CB + 33 * HALF_MIB, WS_Q = WS_U + 33 * HALF_MIB, WS_K = WS_Q + 33 * HALF_MIB, WS_V = WS_K + 33 * HALF_MIB, WS_O = WS_V + 33 * HALF_MIB;
constexpr size_t WS_SA = 512 * MiB, WS_SB = 545 * MiB, WS_MIXED = 578 * MiB, WS_END = 611 * MiB;
static_assert(WS_O + 33 * HALF_MIB <= WS_SA, "ws map");
static_assert((size_t)M * DFF * 2 <= 91 * MiB && (size_t)M * DM * 4 == 66 * MiB && (size_t)M * DA * 2 == 33 * HALF_MIB, "ws sizes");

constexpr int CW_TMO = 0, CW_CODE = 1, CW_BAR = 4096;

namespace pg8 {
#define PG8_LAS __attribute__((address_space(3)))
typedef unsigned short bf16_t;
typedef short bf16x8 __attribute__((ext_vector_type(8)));
typedef float f32x4 __attribute__((ext_vector_type(4)));
typedef unsigned u32x4 __attribute__((ext_vector_type(4)));
constexpr int BM = 256, BK = 64, HALF = 128, HTB = HALF * BK * 2, STAGE_BYTES = 8 * HTB, NXCD = 8, WGM = 8;

__host__ __device__ __forceinline__ int lds_byte(int r, int c) { const int st = (r >> 4) * 2 + (c >> 5), rr = r & 15, cc = c & 31, ob = rr * 64 + cc * 2; return st * 1024 + (ob ^ (((ob >> 9) & 1) << 5)); }
__host__ __device__ __forceinline__ void stage_rc(int b, int& R, int& C) { const int st = b / 1024, sb = b % 1024, swz = sb ^ (((sb >> 9) & 1) << 5); R = (st >> 1) * 16 + swz / 64; C = (st & 1) * 32 + (swz % 64) / 2; }
__host__ __device__ __forceinline__ int perm32(int rho) { const int n = rho >> 4, i = rho & 15; return 8 * (i >> 2) + 4 * n + (i & 3); }

struct Unit { int pm, pn; };
struct Gemm { const bf16_t* A; const bf16_t* Bt; int M, N, K; };

struct StaticOrder {
    int nM, nN, nwg, G, c;
    __host__ __device__ void init(int M_, int N_, int G_, int c_) { nM = M_ / BM; nN = N_ / BM; nwg = nM * nN; G = G_; c = c_; }
    __host__ __device__ bool next(int i, Unit& u) const {
        const long L = (long)i * G + c; if (L >= nwg) return false;
        int wgid = (int)L; { const int q = nwg / NXCD, r = nwg % NXCD, xcd = wgid % NXCD, off = wgid / NXCD; wgid = (xcd < r ? xcd * (q + 1) : r * (q + 1) + (xcd - r) * q) + off; }
        const int nig = WGM * nN, gid = wgid / nig, fm = gid * WGM, gsz = (nM - fm) < WGM ? (nM - fm) : WGM;
        u.pm = fm + ((wgid % nig) % gsz); u.pn = (wgid % nig) / gsz; return true;
    }
    __device__ __forceinline__ void a_ready(const Unit&) const {}
    __device__ __forceinline__ void done(const Unit&) const {}
};

typedef float f32x2_t __attribute__((ext_vector_type(2))); typedef __bf16 bf16x2_t __attribute__((ext_vector_type(2)));
__device__ __forceinline__ unsigned cvt_pk_bf16(float lo, float hi) { f32x2_t v = {lo, hi}; bf16x2_t b = __builtin_convertvector(v, bf16x2_t); return __builtin_bit_cast(unsigned, b); }
__device__ __forceinline__ u32x4 pack8(const f32x4 a, const f32x4 b) { u32x4 w; w.x = cvt_pk_bf16(a[0], a[1]); w.y = cvt_pk_bf16(a[2], a[3]); w.z = cvt_pk_bf16(b[0], b[1]); w.w = cvt_pk_bf16(b[2], b[3]); return w; }
__device__ __forceinline__ float bf_lo(unsigned w) { return __uint_as_float(w << 16); }
__device__ __forceinline__ float bf_hi(unsigned w) { return __uint_as_float(w & 0xffff0000u); }
__device__ __forceinline__ float sigmoidf_(float x) { return __builtin_amdgcn_rcpf(1.0f + __builtin_amdgcn_exp2f(-1.4426950408889634f * x)); }


struct EpiGU {
    static constexpr bool PERM = true, AFTER_DRAIN = false;
    bf16_t* act;
    __device__ __forceinline__ void operator()(const f32x4 (&acc)[2][2][4][2], const Unit& u, int wr, int wc, int fr, int fq) const {
        const int row0 = u.pm * BM + wr * 64 + fr, f0 = u.pn * HALF + wc * 32 + 8 * fq;
#pragma unroll
        for (int ai = 0; ai < 2; ++ai)
#pragma unroll
            for (int m = 0; m < 4; ++m) {
                f32x4 o[2];
#pragma unroll
                for (int n = 0; n < 2; ++n)
#pragma unroll
                    for (int j = 0; j < 4; ++j) { const float g = acc[ai][0][m][n][j], uu = acc[ai][1][m][n][j]; o[n][j] = g * uu * sigmoidf_(g); }
                *(u32x4*)(act + (size_t)(row0 + ai * HALF + m * 16) * DFF + f0) = pack8(o[0], o[1]);
            }
    }
};
struct EpiDN {
    static constexpr bool PERM = false, AFTER_DRAIN = false;
    const float* res_p; const float* res_s; float* out; float scale;
    __device__ __forceinline__ void operator()(const f32x4 (&acc)[2][2][4][2], const Unit& u, int wr, int wc, int fr, int fq) const {
        const int row0 = u.pm * BM + wr * 64 + fr, col0 = u.pn * BM + wc * 32 + 4 * fq;
        const float* rbase = (u.pm < MP / BM) ? res_p : (res_s - (size_t)MP * DM);
#pragma unroll
        for (int ai = 0; ai < 2; ++ai)
#pragma unroll
            for (int m = 0; m < 4; ++m) { const size_t off = (size_t)(row0 + ai * HALF + m * 16) * DM + col0;
                f32x4 rv[2][2];
#pragma unroll
                for (int bj = 0; bj < 2; ++bj)
#pragma unroll
                    for (int n = 0; n < 2; ++n) rv[bj][n] = *(const f32x4*)(rbase + off + bj * HALF + n * 16);
#pragma unroll
                for (int bj = 0; bj < 2; ++bj)
#pragma unroll
                    for (int n = 0; n < 2; ++n) *(f32x4*)(out + off + bj * HALF + n * 16) = rv[bj][n] + acc[ai][bj][m][n] * scale;
            }
    }
};
struct EpiIN {
    static constexpr bool PERM = true, AFTER_DRAIN = false;
    bf16_t *cb, *uu, *q, *k, *v, *sa, *sb; float* dout;
    __device__ __forceinline__ void operator()(const f32x4 (&acc)[2][2][4][2], const Unit& u, int wr, int wc, int fr, int fq) const {
        const int row0 = u.pm * BM + wr * 64 + fr; const int pn = u.pn; const bool prompt = u.pm < MP / BM;
        if (pn >= 4 && pn < 12) {
            const int c8 = (pn - 4) * HALF + wc * 32 + 8 * fq;
#pragma unroll
            for (int ai = 0; ai < 2; ++ai)
#pragma unroll
                for (int m = 0; m < 4; ++m) { const int row = row0 + ai * HALF + m * 16;
                    const f32x4 o0 = acc[ai][0][m][0] * acc[ai][1][m][0], o1 = acc[ai][0][m][1] * acc[ai][1][m][1];
                    *(u32x4*)(uu + (size_t)row * DC + c8) = pack8(o0, o1);
                    if (fr >= 14) {
                        float* dst = nullptr;
                        if (prompt) { if ((u.pm & 7) == 7 && ai == 1 && wr == 1 && m == 3) dst = dout + O_CP + ((size_t)((u.pm >> 3) * 2 + (fr - 14)) * DC + c8); }
                        else dst = dout + O_CS + ((size_t)((8 * ai + 4 * wr + m) * 2 + (fr - 14)) * DC + c8);
                        if (dst) { *(f32x4*)dst = o0; *(f32x4*)(dst + 4) = o1; }
                    }
                }
            return;
        }
        if (pn >= 16 && pn < 24) {
            const bool isk = pn < 20; const int tcol = (isk ? pn - 16 : pn - 20) * BM + wc * 32 + 8 * fq;
            bf16_t* wsb = isk ? k : v;
            float* ob = dout + (prompt ? (isk ? O_KP : O_VP) : (isk ? O_KS : O_VS) - (size_t)MP * DA);
#pragma unroll
            for (int ai = 0; ai < 2; ++ai)
#pragma unroll
                for (int m = 0; m < 4; ++m) { const size_t off = (size_t)(row0 + ai * HALF + m * 16) * DA + tcol;
#pragma unroll
                    for (int bj = 0; bj < 2; ++bj) { const f32x4 v0 = acc[ai][bj][m][0], v1 = acc[ai][bj][m][1];
                        *(f32x4*)(ob + off + bj * HALF) = v0; *(f32x4*)(ob + off + bj * HALF + 4) = v1;
                        *(u32x4*)(wsb + off + bj * HALF) = pack8(v0, v1); } }
            return;
        }
        if (pn >= 24) {
            const bool isa = pn < 32; const int tcol = (isa ? pn - 24 : pn - 32) * BM + wc * 32 + 8 * fq; bf16_t* wsb = isa ? sa : sb;
#pragma unroll
            for (int ai = 0; ai < 2; ++ai)
#pragma unroll
                for (int m = 0; m < 4; ++m) { const size_t off = (size_t)(row0 + ai * HALF + m * 16) * DM + tcol;
#pragma unroll
                    for (int bj = 0; bj < 2; ++bj) { f32x4 v0 = acc[ai][bj][m][0], v1 = acc[ai][bj][m][1];
#pragma unroll
                        for (int j = 0; j < 4; ++j) { v0[j] = sigmoidf_(v0[j]); v1[j] = sigmoidf_(v1[j]); }
                        *(u32x4*)(wsb + off + bj * HALF) = pack8(v0, v1); } }
            return;
        }
        {
            const bool isq = pn >= 12; const int tcol = (isq ? pn - 12 : pn) * BM + wc * 32 + 8 * fq; bf16_t* wsb = isq ? q : cb; const float sc = isq ? QSCALE : 1.0f;
#pragma unroll
            for (int ai = 0; ai < 2; ++ai)
#pragma unroll
                for (int m = 0; m < 4; ++m) { const size_t off = (size_t)(row0 + ai * HALF + m * 16) * DA + tcol;
#pragma unroll
                    for (int bj = 0; bj < 2; ++bj) *(u32x4*)(wsb + off + bj * HALF) = pack8(acc[ai][bj][m][0] * sc, acc[ai][bj][m][1] * sc); }
        }
    }
};
struct EpiCO {
    static constexpr bool PERM = true, AFTER_DRAIN = false;
    const bf16_t* sa; float* t;
    __device__ __forceinline__ void operator()(const f32x4 (&acc)[2][2][4][2], const Unit& u, int wr, int wc, int fr, int fq) const {
        const int row0 = u.pm * BM + wr * 64 + fr, col0 = u.pn * BM + wc * 32 + 8 * fq;
#pragma unroll
        for (int ai = 0; ai < 2; ++ai)
#pragma unroll
            for (int m = 0; m < 4; ++m) { const size_t off = (size_t)(row0 + ai * HALF + m * 16) * DM + col0;
                u32x4 g[2];
#pragma unroll
                for (int bj = 0; bj < 2; ++bj) g[bj] = *(const u32x4*)(sa + off + bj * HALF);
#pragma unroll
                for (int bj = 0; bj < 2; ++bj) { const f32x4 a0 = acc[ai][bj][m][0], a1 = acc[ai][bj][m][1];
                    f32x4 o0, o1; o0[0] = a0[0] * bf_lo(g[bj].x); o0[1] = a0[1] * bf_hi(g[bj].x); o0[2] = a0[2] * bf_lo(g[bj].y); o0[3] = a0[3] * bf_hi(g[bj].y);
                    o1[0] = a1[0] * bf_lo(g[bj].z); o1[1] = a1[1] * bf_hi(g[bj].z); o1[2] = a1[2] * bf_lo(g[bj].w); o1[3] = a1[3] * bf_hi(g[bj].w);
                    *(f32x4*)(t + off + bj * HALF) = o0; *(f32x4*)(t + off + bj * HALF + 4) = o1; } }
    }
};
struct EpiAO {
    static constexpr bool PERM = true, AFTER_DRAIN = false;
    const bf16_t* sb; const float* t; bf16_t* mixed;
    __device__ __forceinline__ void operator()(const f32x4 (&acc)[2][2][4][2], const Unit& u, int wr, int wc, int fr, int fq) const {
        const int row0 = u.pm * BM + wr * 64 + fr, col0 = u.pn * BM + wc * 32 + 8 * fq;
#pragma unroll
        for (int ai = 0; ai < 2; ++ai)
#pragma unroll
            for (int m = 0; m < 4; ++m) { const size_t off = (size_t)(row0 + ai * HALF + m * 16) * DM + col0;
                u32x4 g[2]; f32x4 tv[2][2];
#pragma unroll
                for (int bj = 0; bj < 2; ++bj) { g[bj] = *(const u32x4*)(sb + off + bj * HALF); tv[bj][0] = *(const f32x4*)(t + off + bj * HALF); tv[bj][1] = *(const f32x4*)(t + off + bj * HALF + 4); }
#pragma unroll
                for (int bj = 0; bj < 2; ++bj) { const f32x4 a0 = acc[ai][bj][m][0], a1 = acc[ai][bj][m][1];
                    f32x4 o0, o1; o0[0] = a0[0] * bf_lo(g[bj].x); o0[1] = a0[1] * bf_hi(g[bj].x); o0[2] = a0[2] * bf_lo(g[bj].y); o0[3] = a0[3] * bf_hi(g[bj].y);
                    o1[0] = a1[0] * bf_lo(g[bj].z); o1[1] = a1[1] * bf_hi(g[bj].z); o1[2] = a1[2] * bf_lo(g[bj].w); o1[3] = a1[3] * bf_hi(g[bj].w);
                    *(u32x4*)(mixed + off + bj * HALF) = pack8(o0 + tv[bj][0], o1 + tv[bj][1]); } }
    }
};

template <class Epi, class Sched, bool ALIGN_EPI = false, bool SP2 = false>
__device__ __forceinline__ void gemm_phase(PG8_LAS unsigned char* lds, const Gemm g, const Sched& S, const Epi& E) {
    const int tid = threadIdx.x, wid = __builtin_amdgcn_readfirstlane(tid >> 6), lane = tid & 63, wr = wid >> 2, wc = wid & 3, fr = lane & 15, fq = lane >> 4;
    const int K = g.K, nt = K / BK;
    unsigned voffA[2], voffB[2];
#pragma unroll
    for (int i = 0; i < 2; ++i) { int R, C; stage_rc(tid * 16 + i * 8192, R, C); const int Rb = Epi::PERM ? ((R & ~31) + perm32(R & 31)) : R;
        voffA[i] = (unsigned)(R * K + C) * 2u; voffB[i] = (unsigned)(Rb * K + C) * 2u; }
    const size_t kstep = (size_t)(BK * 2);
    const size_t hstep = (size_t)HALF * K * 2;
    const size_t tstep = 2 * hstep;
    const unsigned ldsw = (unsigned)wid * 1024u;
    const int aoff = lds_byte(wr * 64 + fr, fq * 8), boff = lds_byte(wc * 32 + fr, fq * 8);
#define PG8_SA(b, h) (((b) * 2 + (h)) * HTB)
#define PG8_SB(b, h) ((4 + (b) * 2 + (h)) * HTB)
#define PG8_STAGE(bufoff, gbase, voff) do { _Pragma("unroll") for (int _i = 0; _i < 2; ++_i) \
        __builtin_amdgcn_global_load_lds((const unsigned*)((const char*)(gbase) + (voff)[_i]), (PG8_LAS unsigned*)(lds + (bufoff) + ldsw + _i * 8192), 16, 0, 0); } while (0)
#define PG8_LDA(dst, b, h) do { _Pragma("unroll") for (int m = 0; m < 4; ++m) _Pragma("unroll") for (int k = 0; k < 2; ++k) dst[m][k] = *(const PG8_LAS bf16x8*)(lds + PG8_SA(b, h) + aoff + m * 2048 + k * 1024); } while (0)
#define PG8_LDB(dst, b, h) do { _Pragma("unroll") for (int n = 0; n < 2; ++n) _Pragma("unroll") for (int k = 0; k < 2; ++k) dst[n][k] = *(const PG8_LAS bf16x8*)(lds + PG8_SB(b, h) + boff + n * 2048 + k * 1024); } while (0)
#define PG8_MMA(ai, bj, At, Bt) do { __builtin_amdgcn_s_setprio(1); _Pragma("unroll") for (int m = 0; m < 4; ++m) _Pragma("unroll") for (int n = 0; n < 2; ++n) _Pragma("unroll") for (int k = 0; k < 2; ++k) \
        acc[ai][bj][m][n] = __builtin_amdgcn_mfma_f32_16x16x32_bf16(Bt[n][k], At[m][k], acc[ai][bj][m][n], 0, 0, 0); __builtin_amdgcn_s_setprio(0); } while (0)
#define PG8_WAIT_V(n) asm volatile("s_waitcnt vmcnt(" #n ")" ::: "memory")
#define PG8_WAIT_L(n) asm volatile("s_waitcnt lgkmcnt(" #n ")" ::: "memory")
#define PG8_BAR __builtin_amdgcn_s_barrier()
#define PG8_SCHED __builtin_amdgcn_sched_barrier(0)
    Unit cur, nxt; int ui = 0;
    if (!S.next(0, cur)) return;
    f32x4 acc[2][2][4][2];
#pragma unroll
    for (int a = 0; a < 2; ++a)
#pragma unroll
        for (int b = 0; b < 2; ++b)
#pragma unroll
            for (int m = 0; m < 4; ++m)
#pragma unroll
                for (int n = 0; n < 2; ++n) acc[a][b][m][n] = (f32x4){0.f, 0.f, 0.f, 0.f};
    bf16x8 At[4][2], B0[2][2], B1[2][2];
    const char* cA = (const char*)g.A + (size_t)cur.pm * tstep; const char* cB = (const char*)g.Bt + (size_t)cur.pn * tstep;
    S.a_ready(cur);
    if constexpr (SP2) {
        PG8_STAGE(PG8_SB(0, 0), cB, voffB); PG8_STAGE(PG8_SB(0, 1), cB + hstep, voffB); PG8_STAGE(PG8_SA(0, 0), cA, voffA); PG8_STAGE(PG8_SA(0, 1), cA + hstep, voffA);
        if (wr == 1) PG8_BAR;
        PG8_WAIT_V(2); PG8_BAR;
        PG8_STAGE(PG8_SB(1, 0), cB + kstep, voffB); PG8_STAGE(PG8_SA(1, 0), cA + kstep, voffA); PG8_STAGE(PG8_SB(1, 1), cB + hstep + kstep, voffB);
        PG8_WAIT_V(6); PG8_BAR;
    } else {
        PG8_STAGE(PG8_SB(0, 0), cB, voffB); PG8_STAGE(PG8_SA(0, 0), cA, voffA); PG8_STAGE(PG8_SB(0, 1), cB + hstep, voffB); PG8_STAGE(PG8_SA(0, 1), cA + hstep, voffA);
        if (wr == 1) PG8_BAR;
        PG8_WAIT_V(4); PG8_BAR;
        PG8_STAGE(PG8_SB(1, 0), cB + kstep, voffB); PG8_STAGE(PG8_SA(1, 0), cA + kstep, voffA); PG8_STAGE(PG8_SB(1, 1), cB + hstep + kstep, voffB);
        PG8_WAIT_V(6); PG8_BAR;
    }
    for (;;) {
        const bool has_next = S.next(ui + 1, nxt);
        const char* nA = has_next ? (const char*)g.A + (size_t)nxt.pm * tstep : cA; const char* nB = has_next ? (const char*)g.Bt + (size_t)nxt.pn * tstep : cB;
        for (int t = 0; t < nt; t += 2) {
            const bool last = (t == nt - 2);
            const char* a1 = cA + (size_t)(t + 1) * kstep;
            const char* a2 = last ? nA : cA + (size_t)(t + 2) * kstep; const char* b2 = last ? nB : cB + (size_t)(t + 2) * kstep;
            const char* a3 = a2 + kstep; const char* b3 = b2 + kstep;
            if (last && has_next) S.a_ready(nxt);
            if constexpr (SP2) {
            PG8_LDB(B0, 0, 0); PG8_LDB(B1, 0, 1); PG8_SCHED; PG8_LDA(At, 0, 0); PG8_STAGE(PG8_SA(1, 1), a1 + hstep, voffA);
            PG8_WAIT_V(8); PG8_WAIT_L(0); PG8_BAR; PG8_MMA(0, 0, At, B0); PG8_MMA(0, 1, At, B1); PG8_BAR; PG8_SCHED;
            PG8_LDA(At, 0, 1); PG8_STAGE(PG8_SB(0, 0), b2, voffB); PG8_STAGE(PG8_SB(0, 1), b2 + hstep, voffB); PG8_STAGE(PG8_SA(0, 0), a2, voffA);
            PG8_WAIT_V(8); PG8_WAIT_L(0); PG8_BAR; PG8_MMA(1, 0, At, B0); PG8_MMA(1, 1, At, B1); PG8_BAR; PG8_SCHED;
            PG8_LDB(B0, 1, 0); PG8_LDB(B1, 1, 1); PG8_SCHED; PG8_LDA(At, 1, 0); PG8_STAGE(PG8_SA(0, 1), a2 + hstep, voffA);
            PG8_WAIT_V(8); PG8_WAIT_L(0); PG8_BAR; PG8_MMA(0, 0, At, B0); PG8_MMA(0, 1, At, B1); PG8_BAR; PG8_SCHED;
            PG8_LDA(At, 1, 1); PG8_STAGE(PG8_SB(1, 0), b3, voffB); PG8_STAGE(PG8_SB(1, 1), b3 + hstep, voffB); PG8_STAGE(PG8_SA(1, 0), a3, voffA);
            PG8_WAIT_V(8); PG8_WAIT_L(0); PG8_BAR; PG8_MMA(1, 0, At, B0); PG8_MMA(1, 1, At, B1); PG8_BAR; PG8_SCHED;
            } else {
            PG8_LDB(B0, 0, 0); PG8_SCHED; PG8_LDA(At, 0, 0); PG8_STAGE(PG8_SA(1, 1), a1 + hstep, voffA);
            PG8_WAIT_L(8); PG8_BAR; PG8_WAIT_L(0); PG8_MMA(0, 0, At, B0); PG8_BAR; PG8_SCHED;
            PG8_LDB(B1, 0, 1); PG8_STAGE(PG8_SB(0, 0), b2, voffB);
            PG8_BAR; PG8_WAIT_L(0); PG8_MMA(0, 1, At, B1); PG8_BAR;
            PG8_LDA(At, 0, 1); PG8_STAGE(PG8_SA(0, 0), a2, voffA);
            PG8_BAR; PG8_WAIT_L(0); PG8_MMA(1, 0, At, B0); PG8_BAR; PG8_SCHED;
            PG8_STAGE(PG8_SB(0, 1), b2 + hstep, voffB);
            PG8_WAIT_V(6); PG8_BAR; PG8_MMA(1, 1, At, B1); PG8_BAR;
            PG8_LDB(B0, 1, 0); PG8_SCHED; PG8_LDA(At, 1, 0); PG8_STAGE(PG8_SA(0, 1), a2 + hstep, voffA);
            PG8_WAIT_L(8); PG8_BAR; PG8_WAIT_L(0); PG8_MMA(0, 0, At, B0); PG8_BAR; PG8_SCHED;
            PG8_LDB(B1, 1, 1); PG8_STAGE(PG8_SB(1, 0), b3, voffB);
            PG8_BAR; PG8_WAIT_L(0); PG8_MMA(0, 1, At, B1); PG8_BAR;
            PG8_LDA(At, 1, 1); PG8_STAGE(PG8_SA(1, 0), a3, voffA);
            PG8_BAR; PG8_WAIT_L(0); PG8_MMA(1, 0, At, B0); PG8_BAR; PG8_SCHED;
            PG8_STAGE(PG8_SB(1, 1), b3 + hstep, voffB);
            PG8_WAIT_V(6); PG8_BAR; PG8_MMA(1, 1, At, B1); PG8_BAR;
            }
        }
        if constexpr (ALIGN_EPI) { if (wr == 0) PG8_BAR; }
        if constexpr (!Epi::AFTER_DRAIN) { E(acc, cur, wr, wc, fr, fq); S.done(cur); }
        if (!has_next) break;
#pragma unroll
        for (int a = 0; a < 2; ++a)
#pragma unroll
            for (int b = 0; b < 2; ++b)
#pragma unroll
                for (int m = 0; m < 4; ++m)
#pragma unroll
                    for (int n = 0; n < 2; ++n) acc[a][b][m][n] = (f32x4){0.f, 0.f, 0.f, 0.f};
        cur = nxt; cA = nA; cB = nB; ++ui;
        if constexpr (ALIGN_EPI) { if (wr == 1) PG8_BAR; }
    }
    PG8_WAIT_V(0);
    if constexpr (!ALIGN_EPI) { if (wr == 0) PG8_BAR; }
    PG8_BAR;
#undef PG8_SA
#undef PG8_SB
#undef PG8_STAGE
#undef PG8_LDA
#undef PG8_LDB
#undef PG8_MMA
#undef PG8_WAIT_V
#undef PG8_WAIT_L
#undef PG8_BAR
#undef PG8_SCHED
}
}

namespace sba {
#define LAS __attribute__((address_space(3)))
typedef unsigned short bf16_t;
typedef short bf16x8 __attribute__((ext_vector_type(8)));
typedef short s16x4 __attribute__((ext_vector_type(4)));
typedef float f32x16 __attribute__((ext_vector_type(16)));
typedef float f32x4 __attribute__((ext_vector_type(4)));
typedef unsigned u32x4 __attribute__((ext_vector_type(4)));
typedef unsigned u32x2 __attribute__((ext_vector_type(2)));
#define SBAR() __builtin_amdgcn_sched_barrier(0)
#define KSWZ(row, colB) ((row) * 256 + ((colB) ^ (((row) & 7) << 4)))
constexpr int L_K = 0, L_V = 32768, L_Q = 65536, L_FLAGS = 131072 + 1024, L_RTAB = 131072 + 2048, L_OBUF = 0, TILE_B = 16384;
__device__ __forceinline__ int crow(int r, int hi) { return (r & 3) + 8 * (r >> 2) + 4 * hi; }
__device__ __forceinline__ unsigned cvtpk(float lo, float hi) { return pg8::cvt_pk_bf16(lo, hi); }
__device__ __forceinline__ int v_st(int k, int c) { return (c >> 5) * 4096 + (k >> 3) * 512 + (k & 7) * 64 + (c & 31) * 2; }
__device__ __forceinline__ int v_rd_base(int lane) { return ((lane >> 4) & 1) * 32 + (lane & 3) * 8 + (4 * (lane >> 5) + ((lane & 15) >> 2)) * 64; }
template <int OFF> __device__ __forceinline__ s16x4 tr_read(unsigned vb) { s16x4 r; asm volatile("ds_read_b64_tr_b16 %0, %1 offset:%2" : "=&v"(r) : "v"(vb), "i"(OFF) : "memory"); return r; }

template <bool MASK> __device__ __forceinline__ void sb_block(f32x16& p, float& carry, int kbase, int qpos, int hi) {
    float sp[16];
#pragma unroll
    for (int r = 0; r < 16; ++r) { const float z = p[r]; const float t = __builtin_amdgcn_exp2f(-__builtin_fabsf(z)); const float l = __builtin_amdgcn_logf(1.0f + t);
        sp[r] = __builtin_fmaxf(z, 0.f) + l;
        if (MASK) { if (!(kbase + crow(r, hi) < qpos)) { sp[r] = 0.f; p[r] = -__builtin_inff(); } } }
    float Gp[4], T[4];
#pragma unroll
    for (int g = 0; g < 4; ++g) { const float G = (sp[4 * g] + sp[4 * g + 1]) + (sp[4 * g + 2] + sp[4 * g + 3]);
        auto rr = __builtin_amdgcn_permlane32_swap(__float_as_uint(G), __float_as_uint(G), false, false);
        const float glo = __uint_as_float(rr[0]), ghi = __uint_as_float(rr[1]);
        T[g] = glo + ghi; Gp[g] = hi ? 0.f : ghi; }
    float st = carry;
#pragma unroll
    for (int g = 3; g >= 0; --g) {
        const float base = st + Gp[g];
        const float t3 = base + sp[4 * g + 3], t2 = t3 + sp[4 * g + 2], t1 = t2 + sp[4 * g + 1], t0 = t1 + sp[4 * g + 0];
        p[4 * g + 3] = __builtin_amdgcn_exp2f(p[4 * g + 3] - t3); p[4 * g + 2] = __builtin_amdgcn_exp2f(p[4 * g + 2] - t2);
        p[4 * g + 1] = __builtin_amdgcn_exp2f(p[4 * g + 1] - t1); p[4 * g + 0] = __builtin_amdgcn_exp2f(p[4 * g + 0] - t0);
        st += T[g];
    }
    carry = st;
}
template <bool MASK> __device__ __forceinline__ float sb_part1(f32x16& p, float (&sp)[16], float (&Gp)[4], float (&T)[4], int hi, int q) {
#pragma unroll
    for (int r = 0; r < 16; ++r) { const float z = p[r]; const float t = __builtin_amdgcn_exp2f(-__builtin_fabsf(z)); const float l = __builtin_amdgcn_logf(1.0f + t);
        sp[r] = __builtin_fmaxf(z, 0.f) + l;
        if (MASK) { if (!(crow(r, hi) < q)) { sp[r] = 0.f; p[r] = -__builtin_inff(); } } }
    float tot = 0.f;
#pragma unroll
    for (int g = 0; g < 4; ++g) { const float G = (sp[4 * g] + sp[4 * g + 1]) + (sp[4 * g + 2] + sp[4 * g + 3]);
        auto rr = __builtin_amdgcn_permlane32_swap(__float_as_uint(G), __float_as_uint(G), false, false);
        const float glo = __uint_as_float(rr[0]), ghi = __uint_as_float(rr[1]);
        T[g] = glo + ghi; Gp[g] = hi ? 0.f : ghi; tot += T[g]; }
    return tot;
}
__device__ __forceinline__ void sb_part2(f32x16& p, const float (&sp)[16], const float (&Gp)[4], const float (&T)[4], float carry) {
    float st = carry;
#pragma unroll
    for (int g = 3; g >= 0; --g) {
        const float base = st + Gp[g];
        const float t3 = base + sp[4 * g + 3], t2 = t3 + sp[4 * g + 2], t1 = t2 + sp[4 * g + 1], t0 = t1 + sp[4 * g + 0];
        p[4 * g + 3] = __builtin_amdgcn_exp2f(p[4 * g + 3] - t3); p[4 * g + 2] = __builtin_amdgcn_exp2f(p[4 * g + 2] - t2);
        p[4 * g + 1] = __builtin_amdgcn_exp2f(p[4 * g + 1] - t1); p[4 * g + 0] = __builtin_amdgcn_exp2f(p[4 * g + 0] - t0);
        st += T[g];
    }
}
#define PK8(P, B) (u32x4){cvtpk(P[B], P[B + 1]), cvtpk(P[B + 2], P[B + 3]), cvtpk(P[B + 4], P[B + 5]), cvtpk(P[B + 6], P[B + 7])}

template <int D0> __device__ __forceinline__ void pv_one(f32x16& od, unsigned vb, bf16x8 pa0, bf16x8 pa1, bf16x8 pa2, bf16x8 pa3) {
    const s16x4 l0 = tr_read<D0 * 4096 + 0 * 1024>(vb), h0 = tr_read<D0 * 4096 + 0 * 1024 + 512>(vb), l1 = tr_read<D0 * 4096 + 1 * 1024>(vb), h1 = tr_read<D0 * 4096 + 1 * 1024 + 512>(vb);
    const s16x4 l2 = tr_read<D0 * 4096 + 2 * 1024>(vb), h2 = tr_read<D0 * 4096 + 2 * 1024 + 512>(vb), l3 = tr_read<D0 * 4096 + 3 * 1024>(vb), h3 = tr_read<D0 * 4096 + 3 * 1024 + 512>(vb);
    asm volatile("s_waitcnt lgkmcnt(0)" ::: "memory"); SBAR();
#define PKV(L, H) (bf16x8){L[0], L[1], L[2], L[3], H[0], H[1], H[2], H[3]}
    od = __builtin_amdgcn_mfma_f32_32x32x16_bf16(pa0, PKV(l0, h0), od, 0, 0, 0);
    od = __builtin_amdgcn_mfma_f32_32x32x16_bf16(pa1, PKV(l1, h1), od, 0, 0, 0);
    od = __builtin_amdgcn_mfma_f32_32x32x16_bf16(pa2, PKV(l2, h2), od, 0, 0, 0);
    od = __builtin_amdgcn_mfma_f32_32x32x16_bf16(pa3, PKV(l3, h3), od, 0, 0, 0);
#undef PKV
}

__device__ __forceinline__ void prompt_unit(int b, int h, int qb, const bf16_t* Q, const bf16_t* Kg, const bf16_t* Vg, bf16_t* O, LAS unsigned char* lds) {
    const int tid = threadIdx.x, lane = tid & 63, r32 = lane & 31, hi = lane >> 5; const int wid = __builtin_amdgcn_readfirstlane(tid >> 6);
    const size_t rowbase = (size_t)b * SEQ; const int qw0 = 256 * qb + 32 * wid;
    const bf16_t* Kh = Kg + rowbase * DA + h * HD; const bf16_t* Vh = Vg + rowbase * DA + h * HD;
    LAS unsigned char* Ql = lds + L_Q + wid * 8192 + lane * 16;
    { const bf16_t* Qw = Q + (rowbase + qw0 + r32) * DA + h * HD + hi * 8;
#pragma unroll
      for (int d0 = 0; d0 < 8; ++d0) *(LAS bf16x8*)(Ql + d0 * 1024) = *(const bf16x8*)(Qw + d0 * 16); }
    const int krow0 = 4 * wid + (lane >> 4), krow1 = krow0 + 32;
    const bf16_t* ksrc0 = Kh + (size_t)krow0 * DA + (((lane & 15) ^ (krow0 & 7)) * 8);
    const bf16_t* ksrc1 = Kh + (size_t)krow1 * DA + (((lane & 15) ^ (krow1 & 7)) * 8);
    const bf16_t* vsrc0 = Vh + (size_t)(16 * (wid & 3) + (lane >> 2)) * DA + (wid >> 2) * 32 + (lane & 3) * 8;
    const bf16_t* vsrc1 = vsrc0 + 64;
    const unsigned vb0 = (unsigned)(uintptr_t)(lds + L_V) + (unsigned)v_rd_base(lane);
    LAS unsigned* flags = (LAS unsigned*)(lds + L_FLAGS);
#define SLOAD(k0, bb) do { const size_t go_ = (size_t)(k0) * DA; \
        __builtin_amdgcn_global_load_lds((const unsigned*)(ksrc0 + go_), (LAS unsigned*)(lds + L_K + (bb) * TILE_B + wid * 1024), 16, 0, 0); \
        __builtin_amdgcn_global_load_lds((const unsigned*)(ksrc1 + go_), (LAS unsigned*)(lds + L_K + (bb) * TILE_B + (wid + 8) * 1024), 16, 0, 0); \
        __builtin_amdgcn_global_load_lds((const unsigned*)(vsrc0 + go_), (LAS unsigned*)(lds + L_V + (bb) * TILE_B + wid * 1024), 16, 0, 0); \
        __builtin_amdgcn_global_load_lds((const unsigned*)(vsrc1 + go_), (LAS unsigned*)(lds + L_V + (bb) * TILE_B + (wid + 8) * 1024), 16, 0, 0); } while (0)
    const int NT = 4 * qb + 4;
    f32x16 o[4]; o[0] = f32x16{}; o[1] = f32x16{}; o[2] = f32x16{}; o[3] = f32x16{};
    float carry = 0.f; bool wdone = false; const int qpos = qw0 + r32;
    SLOAD(64 * (NT - 1), 0); asm volatile("s_waitcnt vmcnt(0)" ::: "memory"); __syncthreads();
    for (int it = 0; it < NT; ++it) {
        const int jt = NT - 1 - it, bb = it & 1, k0 = 64 * jt; const bool have_next = jt > 0;
        if (have_next) SLOAD(64 * (jt - 1), bb ^ 1);
        if (!wdone && k0 <= qw0) {
            f32x16 p0 = f32x16{}, p1 = f32x16{};
            const LAS unsigned char* Kb = lds + L_K + bb * TILE_B;
#pragma unroll
            for (int d0 = 0; d0 < 8; ++d0) { const int cb = (d0 * 16 + hi * 8) * 2;
                const bf16x8 b0 = *(const LAS bf16x8*)(Kb + KSWZ(r32, cb)); const bf16x8 b1 = *(const LAS bf16x8*)(Kb + KSWZ(32 + r32, cb));
                const bf16x8 qf = *(const LAS bf16x8*)(Ql + d0 * 1024);
                p0 = __builtin_amdgcn_mfma_f32_32x32x16_bf16(b0, qf, p0, 0, 0, 0); p1 = __builtin_amdgcn_mfma_f32_32x32x16_bf16(b1, qf, p1, 0, 0, 0);
                if (d0 & 1) SBAR(); }
            if (k0 + 64 > qw0) { sb_block<true>(p1, carry, k0 + 32, qpos, hi); SBAR(); sb_block<true>(p0, carry, k0, qpos, hi); }
            else { sb_block<false>(p1, carry, k0 + 32, qpos, hi); SBAR(); sb_block<false>(p0, carry, k0, qpos, hi); }
            SBAR();
            const u32x4 w0 = PK8(p0, 0), w1 = PK8(p0, 8), w2 = PK8(p1, 0), w3 = PK8(p1, 8);
            const bf16x8 pa0 = __builtin_bit_cast(bf16x8, w0), pa1 = __builtin_bit_cast(bf16x8, w1), pa2 = __builtin_bit_cast(bf16x8, w2), pa3 = __builtin_bit_cast(bf16x8, w3);
            const unsigned vb = vb0 + bb * TILE_B;
            pv_one<0>(o[0], vb, pa0, pa1, pa2, pa3); pv_one<1>(o[1], vb, pa0, pa1, pa2, pa3); pv_one<2>(o[2], vb, pa0, pa1, pa2, pa3); pv_one<3>(o[3], vb, pa0, pa1, pa2, pa3);
            wdone = __all(carry > SB_THRESH) != 0;
        }
        if (lane == 0) flags[bb * 8 + wid] = wdone ? 1u : 0u;
        asm volatile("s_waitcnt vmcnt(0)" ::: "memory"); __syncthreads();
        unsigned all = 1u;
#pragma unroll
        for (int w = 0; w < 8; ++w) all &= flags[bb * 8 + w];
        if (all) break;
    }
    bf16_t* Ow = O + (rowbase + qw0) * DA + h * HD;
#pragma unroll
    for (int r = 0; r < 16; ++r) { const int orow = crow(r, hi);
#pragma unroll
        for (int d0 = 0; d0 < 4; ++d0) Ow[(size_t)orow * DA + d0 * 32 + r32] = (bf16_t)(cvtpk(o[d0][r], 0.f) & 0xffffu); }
    __syncthreads();
#undef SLOAD
}

__device__ __forceinline__ void sample_unit(int b, int h, const bf16_t* Q, const bf16_t* Kn, const bf16_t* Vn, const float* cK, const float* cV, bf16_t* O, LAS unsigned char* lds) {
    const int tid = threadIdx.x, lane = tid & 63, r32 = lane & 31, hi = lane >> 5; const int wid = __builtin_amdgcn_readfirstlane(tid >> 6);
    const size_t row0 = (size_t)MP + (size_t)b * DECS;
    LAS float* rtab = (LAS float*)(lds + L_RTAB);
    f32x16 o[4]; o[0] = f32x16{}; o[1] = f32x16{}; o[2] = f32x16{}; o[3] = f32x16{};
    float carry = 0.f;
    constexpr int NTILE = PAST / 32 + 1;
    for (int rnd = 0; rnd * 8 < NTILE; ++rnd) {
        const int j = rnd * 8 + wid; const bool valid = j < NTILE; const int par = rnd & 1;
        f32x16 p = f32x16{}; float sp[16], Gp[4], T[4]; float tot = 0.f;
        if (valid) {
            const bf16_t* Qw = Q + (row0 + (r32 & 15)) * DA + h * HD + hi * 8;
            if (j == 0) {
                const bf16_t* Kw = Kn + (row0 + (r32 & 15)) * DA + h * HD + hi * 8;
#pragma unroll
                for (int d0 = 0; d0 < 8; ++d0) { bf16x8 kf = *(const bf16x8*)(Kw + d0 * 16), qf = *(const bf16x8*)(Qw + d0 * 16);
                    if (r32 >= DECS) { kf = (bf16x8){0, 0, 0, 0, 0, 0, 0, 0}; qf = kf; }
                    p = __builtin_amdgcn_mfma_f32_32x32x16_bf16(kf, qf, p, 0, 0, 0); }
                tot = sb_part1<true>(p, sp, Gp, T, hi, r32);
            } else {
                const float* Ku = cK + (((size_t)b * PAST + (PAST - 32 * j)) * NH + h) * HD;
                const int klo = r32 * NH * HD + hi * 8;
#pragma unroll
                for (int d0 = 0; d0 < 8; ++d0) { const f32x4 a = *(const f32x4*)(Ku + d0 * 16 + klo), c = *(const f32x4*)(Ku + d0 * 16 + 4 + klo);
                    const u32x4 w = {cvtpk(a[0], a[1]), cvtpk(a[2], a[3]), cvtpk(c[0], c[1]), cvtpk(c[2], c[3])};
                    bf16x8 qf = *(const bf16x8*)(Qw + d0 * 16); if (r32 >= DECS) qf = (bf16x8){0, 0, 0, 0, 0, 0, 0, 0};
                    p = __builtin_amdgcn_mfma_f32_32x32x16_bf16(__builtin_bit_cast(bf16x8, w), qf, p, 0, 0, 0);
                    if ((d0 & 3) == 3) asm volatile("" ::: "memory"); }
                tot = sb_part1<false>(p, sp, Gp, T, hi, r32);
            }
        }
        if (hi == 0) rtab[(par * 8 + wid) * 32 + r32] = tot;
        __syncthreads();
        float cin = carry, total = 0.f;
#pragma unroll
        for (int w = 0; w < 8; ++w) { const float x = rtab[(par * 8 + w) * 32 + r32]; if (w < wid) cin += x; total += x; }
        if (valid) {
            sb_part2(p, sp, Gp, T, cin);
            const u32x4 w0 = PK8(p, 0), w1 = PK8(p, 8);
            const bf16x8 pa0 = __builtin_bit_cast(bf16x8, w0), pa1 = __builtin_bit_cast(bf16x8, w1);
            if (j == 0) {
#pragma unroll
                for (int d0 = 0; d0 < 4; ++d0) { bf16x8 f;
#pragma unroll
                    for (int e = 0; e < 8; ++e) f[e] = (short)Vn[(row0 + 4 * hi + (e & 3) + 8 * (e >> 2)) * DA + h * HD + d0 * 32 + r32];
                    o[d0] = __builtin_amdgcn_mfma_f32_32x32x16_bf16(pa0, f, o[d0], 0, 0, 0); }
            } else {
                const float* Vu = cV + (((size_t)b * PAST + (PAST - 32 * j)) * NH + h) * HD;
                const int vlo = 4 * hi * NH * HD + r32;
#pragma unroll
                for (int d0 = 0; d0 < 4; ++d0) {
                    float x[16];
#pragma unroll
                    for (int e = 0; e < 16; ++e) x[e] = (Vu + ((16 * (e >> 3) + (e & 3) + 8 * ((e >> 2) & 1)) * NH * HD + d0 * 32))[vlo];
                    const u32x4 wa = {cvtpk(x[0], x[1]), cvtpk(x[2], x[3]), cvtpk(x[4], x[5]), cvtpk(x[6], x[7])}, wb = {cvtpk(x[8], x[9]), cvtpk(x[10], x[11]), cvtpk(x[12], x[13]), cvtpk(x[14], x[15])};
                    o[d0] = __builtin_amdgcn_mfma_f32_32x32x16_bf16(pa0, __builtin_bit_cast(bf16x8, wa), o[d0], 0, 0, 0);
                    o[d0] = __builtin_amdgcn_mfma_f32_32x32x16_bf16(pa1, __builtin_bit_cast(bf16x8, wb), o[d0], 0, 0, 0);
                    asm volatile("" ::: "memory");
                }
            }
        }
        carry += total;
        if (__all(r32 >= DECS || carry > SB_THRESH)) break;
    }
    LAS float* obuf = (LAS float*)(lds + L_OBUF);
#pragma unroll
    for (int r = 0; r < 8; ++r) { const int q = crow(r, hi);
#pragma unroll
        for (int d0 = 0; d0 < 4; ++d0) obuf[(wid * 16 + q) * 128 + d0 * 32 + r32] = o[d0][r]; }
    __syncthreads();
    { const int q = tid >> 5, d = (tid & 31) * 4; f32x4 s = {0.f, 0.f, 0.f, 0.f};
#pragma unroll
      for (int w = 0; w < 8; ++w) s += *(const LAS f32x4*)(obuf + (w * 16 + q) * 128 + d);
      u32x2 w2; w2.x = cvtpk(s[0], s[1]); w2.y = cvtpk(s[2], s[3]);
      *(u32x2*)(O + (row0 + q) * DA + h * HD + d) = w2; }
    __syncthreads();
}
#undef SBAR
#undef PK8
}

constexpr int NWAVES = 8;
constexpr int N_LAUNCHES = MK_N_LAUNCHES;
constexpr int NPHASE = 13;
constexpr int RING_OFF = 0, RING_BYTES = 131072;
constexpr int LDSCTL_OFF = RING_BYTES, MISC_OFF = LDSCTL_OFF + 320;
constexpr int LDS_BYTES = 147456;

#define GAS __attribute__((address_space(1)))
typedef unsigned short bf16;
typedef unsigned v4u __attribute__((ext_vector_type(4)));
typedef float f32x4 __attribute__((ext_vector_type(4)));
typedef GAS unsigned gu32;
#define RLX_AGENT __ATOMIC_RELAXED, __HIP_MEMORY_SCOPE_AGENT
#define LDS_WAIT() asm volatile("s_waitcnt lgkmcnt(0)" ::: "memory")
#define VM_WAIT() asm volatile("s_waitcnt vmcnt(0)" ::: "memory")
__device__ __forceinline__ unsigned f2bf(float f) { unsigned u = __builtin_bit_cast(unsigned, f); return (u + 0x7fffu + ((u >> 16) & 1u)) >> 16; }
__device__ __forceinline__ unsigned pk2(float lo, float hi) { return f2bf(lo) | (f2bf(hi) << 16); }

#define XB_TMO      128
#define XB_XCNT(j)  (256  + 64 * (j))
#define XB_XSUB(j)  (1280 + 64 * (j))
#define XB_XGEN(j)  (2304 + 64 * (j))
#define XB_TOP      3328
#define XB_TOPGEN   3392
#define XCD_BAR_WORDS 3456
#define XB_SPIN_CAP (1u << 18)
__device__ __forceinline__ unsigned xb_ld(unsigned* p)              { return __hip_atomic_load(p, __ATOMIC_RELAXED, __HIP_MEMORY_SCOPE_AGENT); }
__device__ __forceinline__ unsigned xb_add(unsigned* p, unsigned v) { return __hip_atomic_fetch_add(p, v, __ATOMIC_RELAXED, __HIP_MEMORY_SCOPE_AGENT); }
__device__ __forceinline__ unsigned xb_xcc_id() { return (unsigned)__builtin_amdgcn_s_getreg((3 << 11) | 20) & 0xFu; }
#define XB_SPIN(cond, bar) do { unsigned _sp = 0; while (cond) { __builtin_amdgcn_s_sleep(1); \
    if ((++_sp & 255u) == 0u) { if (xb_ld(&(bar)[XB_TMO])) break; if (_sp > XB_SPIN_CAP) { atomicAdd(&(bar)[XB_TMO], 1u); break; } } } } while (0)
struct XcdBarrier { unsigned* bar; unsigned x; volatile LAS unsigned* st; };
__device__ __forceinline__ XcdBarrier xcd_barrier_post(unsigned* bar, volatile LAS unsigned* st) {
    XcdBarrier b; b.bar = bar; b.x = xb_xcc_id(); b.st = st;
    if (threadIdx.x == 0) (void)xb_add(&bar[XB_XCNT(b.x)], 1u);
    return b;
}
__device__ __forceinline__ void xcd_barrier_complete(unsigned* bar, unsigned x, unsigned& nloc, unsigned& nx) {
    const unsigned G = gridDim.x * gridDim.y * gridDim.z;
    unsigned sum, cnt, mine, sp = 0u;
    for (;;) {
        sum = 0u; cnt = 0u; mine = 0u;
#pragma unroll
        for (unsigned j = 0; j < 16; ++j) { const unsigned c = xb_ld(&bar[XB_XCNT(j)]); sum += c; cnt += (c > 0u) ? 1u : 0u; mine = (j == x) ? c : mine; }
        if (sum == G) break;
        __builtin_amdgcn_s_sleep(1);
        if ((++sp & 255u) == 0u) { if (xb_ld(&bar[XB_TMO])) break; if (sp > XB_SPIN_CAP) { atomicAdd(&bar[XB_TMO], 1u); break; } }
    }
    nloc = mine > 0u ? mine : 1u; nx = cnt > 0u ? cnt : 1u;
}
__device__ __forceinline__ void xcd_barrier(const XcdBarrier& b) {
    asm volatile("s_waitcnt vmcnt(0)" ::: "memory");
    __syncthreads();
    if (threadIdx.x == 0) {
        unsigned* bar = b.bar;
        __builtin_amdgcn_s_waitcnt(0);
        unsigned nloc = b.st[0], nx = b.st[1];
        if (nloc == 0u) { xcd_barrier_complete(bar, b.x, nloc, nx); b.st[0] = nloc; b.st[1] = nx; }
        const unsigned old = xb_add(&bar[XB_XSUB(b.x)], 1u);
        const unsigned gen = old / nloc;
        if (old + 1u == (gen + 1u) * nloc) {
            __builtin_amdgcn_fence(__ATOMIC_RELEASE, "agent");
            asm volatile("s_waitcnt vmcnt(0)" ::: "memory");
            const unsigned og = xb_add(&bar[XB_TOP], 1u);
            const unsigned tg = og / nx;
            if (og + 1u == (tg + 1u) * nx) xb_add(&bar[XB_TOPGEN], 1u);
            else XB_SPIN(xb_ld(&bar[XB_TOPGEN]) == tg, bar);
            __builtin_amdgcn_fence(__ATOMIC_ACQUIRE, "agent");
            xb_add(&bar[XB_XGEN(b.x)], 1u);
            asm volatile("s_waitcnt vmcnt(0)" ::: "memory");
        } else {
            XB_SPIN(xb_ld(&bar[XB_XGEN(b.x)]) == gen, bar);
            __builtin_amdgcn_fence(__ATOMIC_ACQUIRE, "agent");
            asm volatile("s_waitcnt vmcnt(0)" ::: "memory");
        }
    }
    __syncthreads();
}

__device__ __forceinline__ float wave_sum(float v) {
#pragma unroll
    for (int o = 1; o < 64; o <<= 1) v += __shfl_xor(v, o);
    return v;
}
__device__ __forceinline__ int map_row(int mode, int n0) {
    if (mode == 1) { const bool up = n0 >= DFF; const int f = up ? n0 - DFF : n0; return (f >> 7) * 256 + (up ? 128 : 0) + (f & 127); }
    if (mode == 2) { if (n0 >= DC && n0 < 3 * DC) { const bool x = n0 >= 2 * DC; const int c = x ? n0 - 2 * DC : n0 - DC; return DC + (c >> 7) * 256 + (x ? 128 : 0) + (c & 127); } return n0; }
    return n0;
}
__device__ __forceinline__ void p0_transpose_item(const float* W, int K, int N, bf16* WT, int mode, LAS float* scr, int item, int lane) {
    const int nblk = N / 32, kb = item / nblk, nb = item % nblk, k0 = 64 * kb, n0 = 32 * nb; const int orow0 = map_row(mode, n0);
#pragma unroll 8
    for (int i = 0; i < 32; ++i) { const int kk = 2 * i + (lane >> 5); scr[kk * 33 + (lane & 31)] = W[(size_t)(k0 + kk) * N + n0 + (lane & 31)]; }
    LDS_WAIT(); asm volatile("" ::: "memory");
    const int c = lane & 7;
#pragma unroll
    for (int j = 0; j < 4; ++j) { const int n = (lane >> 3) + 8 * j; const LAS float* s = scr + (8 * c) * 33 + n;
        v4u o; o.x = pk2(s[0 * 33], s[1 * 33]); o.y = pk2(s[2 * 33], s[3 * 33]); o.z = pk2(s[4 * 33], s[5 * 33]); o.w = pk2(s[6 * 33], s[7 * 33]);
        *(GAS v4u*)(WT + (size_t)(orow0 + n) * K + k0 + 8 * c) = o; }
    LDS_WAIT(); asm volatile("" ::: "memory");
}
template <bool OUT_F32> __device__ __forceinline__ void rms_row(const float* xrow, const float* g, void* orow, int lane) {
    const f32x4* xr = (const f32x4*)xrow + lane; const f32x4* gr = (const f32x4*)g + lane;
    f32x4 v[8]; float s = 0.f;
#pragma unroll
    for (int j = 0; j < 8; ++j) { v[j] = xr[64 * j]; s += (v[j].x * v[j].x + v[j].y * v[j].y) + (v[j].z * v[j].z + v[j].w * v[j].w); }
    const float rstd = 1.0f / sqrtf(wave_sum(s) * (1.0f / DM) + EPS);
#pragma unroll
    for (int j = 0; j < 8; ++j) { const f32x4 gv = gr[64 * j]; const f32x4 y = v[j] * rstd * gv;
        if (OUT_F32) ((f32x4*)orow + lane)[64 * j] = y;
        else ((unsigned long long*)orow + lane)[64 * j] = (unsigned long long)pk2(y.x, y.y) | ((unsigned long long)pk2(y.z, y.w) << 32); }
}

struct Args { const float* in[18]; float* out; unsigned char* ws; int ph_lo, ph_hi, li, pad; };

__global__ void __launch_bounds__(NWAVES * 64, 2) mk_fwd(Args args) {
    extern __shared__ __attribute__((aligned(16))) unsigned char lds_raw[];
    LAS unsigned char* lds = (LAS unsigned char*)lds_raw;
    volatile LAS unsigned* MISC = (volatile LAS unsigned*)(lds + MISC_OFF);
    const int tid = threadIdx.x, lane = tid & 63, wave = __builtin_amdgcn_readfirstlane(tid >> 6);
    const int G = gridDim.x; const int bx = blockIdx.x; const int vcu = (G % 8 == 0) ? (bx % 8) * (G / 8) + bx / 8 : bx;
#define ws (args.ws)
    gu32* ctl = (gu32*)(ws + WS_CTL);
#define x_prompt (args.in[0])
#define x_sample (args.in[1])
#define cache_k (args.in[2])
#define cache_v (args.in[3])
#define state_conv (args.in[4])
#define g_ffn1 (args.in[5])
#define w_gu1 (args.in[6])
#define w_dn1 (args.in[7])
#define g_mix (args.in[8])
#define w_in (args.in[9])
#define conv_w (args.in[10])
#define w_co (args.in[11])
#define w_ao (args.in[12])
#define w_o (args.in[13])
#define g_ffn2 (args.in[14])
#define w_gu2 (args.in[15])
#define w_dn2 (args.in[16])
#define g_fin (args.in[17])
#define out (args.out)
#define Wgu1 ((bf16*)(ws + WS_WGU1))
#define Wdn1 ((bf16*)(ws + WS_WDN1))
#define Win ((bf16*)(ws + WS_WIN))
#define Wco ((bf16*)(ws + WS_WCO))
#define Wao ((bf16*)(ws + WS_WAO))
#define Wo ((bf16*)(ws + WS_WO))
#define Wgu2 ((bf16*)(ws + WS_WGU2))
#define Wdn2 ((bf16*)(ws + WS_WDN2))
#define XN ((bf16*)(ws + WS_XN))
#define XG ((bf16*)(ws + WS_XG))
#define ACT ((bf16*)(ws + WS_ACT))
#define X ((float*)(ws + WS_X))
#define T ((float*)(ws + WS_T))
#define CB ((bf16*)(ws + WS_CB))
#define U ((bf16*)(ws + WS_U))
#define Qb ((bf16*)(ws + WS_Q))
#define Kb ((bf16*)(ws + WS_K))
#define Vb ((bf16*)(ws + WS_V))
#define Ob ((bf16*)(ws + WS_O))
#define SA ((bf16*)(ws + WS_SA))
#define SBg ((bf16*)(ws + WS_SB))
#define MIXED ((bf16*)(ws + WS_MIXED))
    for (int u = tid; u < (LDS_BYTES - LDSCTL_OFF) / 4; u += NWAVES * 64) ((LAS unsigned*)(lds + LDSCTL_OFF))[u] = 0u;
    __syncthreads();
    XcdBarrier bar; bar.bar = (unsigned*)(ctl + CW_BAR); bar.x = 0; bar.st = nullptr;
    if (N_LAUNCHES == 1) bar = xcd_barrier_post((unsigned*)(ctl + CW_BAR), MISC + 8);
    const int lo = args.ph_lo, hi = args.ph_hi;
#ifndef PH_MASK
#define PH_MASK 0x1fff
#endif
#define IN(k) (((PH_MASK >> (k)) & 1) && lo <= (k) && (k) < hi)
#define SEAM(k) do { if (IN(k) && IN((k) + 1)) xcd_barrier(bar); } while (0)
    const int gw = vcu * NWAVES + wave, NGW = G * NWAVES;

    if (IN(0)) {
        LAS float* scr = (LAS float*)(lds + RING_OFF + wave * 16384);
        constexpr int I_GU = (DM / 64) * (2 * DFF / 32), I_DN = (DFF / 64) * (DM / 32), I_IN = (DM / 64) * (DIN / 32), I_CO = (DC / 64) * (DM / 32), I_AO = (DA / 64) * (DM / 32), I_WO = (DM / 64) * (DM / 32);
        constexpr int NITEMS = 2 * I_GU + 2 * I_DN + I_IN + I_CO + I_AO + I_WO;
        for (int it = gw; it < NITEMS; it += NGW) {
            int r = it;
            if (r < I_GU) { p0_transpose_item(w_gu1, DM, 2 * DFF, Wgu1, 1, scr, r, lane); continue; } r -= I_GU;
            if (r < I_DN) { p0_transpose_item(w_dn1, DFF, DM, Wdn1, 0, scr, r, lane); continue; } r -= I_DN;
            if (r < I_IN) { p0_transpose_item(w_in, DM, DIN, Win, 2, scr, r, lane); continue; } r -= I_IN;
            if (r < I_CO) { p0_transpose_item(w_co, DC, DM, Wco, 0, scr, r, lane); continue; } r -= I_CO;
            if (r < I_AO) { p0_transpose_item(w_ao, DA, DM, Wao, 0, scr, r, lane); continue; } r -= I_AO;
            if (r < I_WO) { p0_transpose_item(w_o, DM, DM, Wo, 0, scr, r, lane); continue; } r -= I_WO;
            if (r < I_GU) { p0_transpose_item(w_gu2, DM, 2 * DFF, Wgu2, 1, scr, r, lane); continue; } r -= I_GU;
            p0_transpose_item(w_dn2, DFF, DM, Wdn2, 0, scr, r, lane);
        }
        for (int m = gw; m < M; m += NGW) { const float* xr = (m < MP) ? x_prompt + (size_t)m * DM : x_sample + (size_t)(m - MP) * DM; rms_row<false>(xr, g_ffn1, XN + (size_t)m * DM, lane); }
    }
    SEAM(0);
    if (IN(1)) { pg8::Gemm g{XN, Wgu1, M, 2 * DFF, DM}; pg8::StaticOrder S; S.init(M, 2 * DFF, G, bx); pg8::EpiGU E{ACT};
        pg8::gemm_phase<pg8::EpiGU, pg8::StaticOrder, true, true>(lds + RING_OFF, g, S, E); }
    SEAM(1);
    if (IN(2)) { pg8::Gemm g{ACT, Wdn1, M, DM, DFF}; pg8::StaticOrder S; S.init(M, DM, G, bx); pg8::EpiDN E{x_prompt, x_sample, X, 0.5f};
        pg8::gemm_phase<pg8::EpiDN, pg8::StaticOrder, true, true>(lds + RING_OFF, g, S, E); }
    SEAM(2);
    if (IN(3)) { for (int m = gw; m < M; m += NGW) rms_row<false>(X + (size_t)m * DM, g_mix, XG + (size_t)m * DM, lane); }
    SEAM(3);
    if (IN(4)) { pg8::Gemm g{XG, Win, M, DIN, DM}; pg8::StaticOrder S; S.init(M, DIN, G, bx); pg8::EpiIN E{CB, U, Qb, Kb, Vb, SA, SBg, out};
        pg8::gemm_phase<pg8::EpiIN, pg8::StaticOrder, true, true>(lds + RING_OFF, g, S, E); }
    SEAM(4);
    if (IN(5)) {
#if !defined(P5_OFF_A)
        for (int u = vcu; u < NB * NH * (SEQ / 256); u += G) { const int bh = u >> 3, qb = u & 7; sba::prompt_unit(bh / NH, bh % NH, qb, Qb, Kb, Vb, Ob, lds + RING_OFF); }
#endif
#if !defined(P5_OFF_B)
        for (int u = vcu; u < DECB * NH; u += G) { const int uu = (u * 2) % (DECB * NH) + (u * 2) / (DECB * NH);
            sba::sample_unit(uu / NH, uu % NH, Qb, Kb, Vb, cache_k, cache_v, Ob, lds + RING_OFF); }
#endif
        for (int it = vcu; it < M / 4; it += G) {
            const int m = 4 * it + (tid >> 7), cg = (tid & 127) * 8;
            const int t = (m < MP) ? (m % SEQ) : ((m - MP) % DECS);
            float u0[8], u1[8], u2[8];
            { const v4u w = *(const v4u*)(U + (size_t)m * DC + cg); u0[0] = pg8::bf_lo(w.x); u0[1] = pg8::bf_hi(w.x); u0[2] = pg8::bf_lo(w.y); u0[3] = pg8::bf_hi(w.y); u0[4] = pg8::bf_lo(w.z); u0[5] = pg8::bf_hi(w.z); u0[6] = pg8::bf_lo(w.w); u0[7] = pg8::bf_hi(w.w); }
            if (t >= 1) { const v4u w = *(const v4u*)(U + (size_t)(m - 1) * DC + cg); u1[0] = pg8::bf_lo(w.x); u1[1] = pg8::bf_hi(w.x); u1[2] = pg8::bf_lo(w.y); u1[3] = pg8::bf_hi(w.y); u1[4] = pg8::bf_lo(w.z); u1[5] = pg8::bf_hi(w.z); u1[6] = pg8::bf_lo(w.w); u1[7] = pg8::bf_hi(w.w); }
            else if (m >= MP) { const float* s = state_conv + ((size_t)((m - MP) / DECS) * 2 + 1) * DC + cg; for (int e = 0; e < 8; ++e) u1[e] = s[e]; }
            else { for (int e = 0; e < 8; ++e) u1[e] = 0.f; }
            if (t >= 2) { const v4u w = *(const v4u*)(U + (size_t)(m - 2) * DC + cg); u2[0] = pg8::bf_lo(w.x); u2[1] = pg8::bf_hi(w.x); u2[2] = pg8::bf_lo(w.y); u2[3] = pg8::bf_hi(w.y); u2[4] = pg8::bf_lo(w.z); u2[5] = pg8::bf_hi(w.z); u2[6] = pg8::bf_lo(w.w); u2[7] = pg8::bf_hi(w.w); }
            else if (m >= MP) { const float* s = state_conv + ((size_t)((m - MP) / DECS) * 2 + t) * DC + cg; for (int e = 0; e < 8; ++e) u2[e] = s[e]; }
            else { for (int e = 0; e < 8; ++e) u2[e] = 0.f; }
            const v4u cw = *(const v4u*)(CB + (size_t)m * DC + cg);
            float c[8]; c[0] = pg8::bf_lo(cw.x); c[1] = pg8::bf_hi(cw.x); c[2] = pg8::bf_lo(cw.y); c[3] = pg8::bf_hi(cw.y); c[4] = pg8::bf_lo(cw.z); c[5] = pg8::bf_hi(cw.z); c[6] = pg8::bf_lo(cw.w); c[7] = pg8::bf_hi(cw.w);
            float r[8];
#pragma unroll
            for (int e = 0; e < 8; ++e) r[e] = c[e] * (conv_w[cg + e] * u2[e] + conv_w[DC + cg + e] * u1[e] + conv_w[2 * DC + cg + e] * u0[e]);
            v4u o; o.x = pk2(r[0], r[1]); o.y = pk2(r[2], r[3]); o.z = pk2(r[4], r[5]); o.w = pk2(r[6], r[7]);
            *(v4u*)(CB + (size_t)m * DC + cg) = o;
        }
    }
    SEAM(5);
    if (IN(6)) { pg8::Gemm g{CB, Wco, M, DM, DC}; pg8::StaticOrder S; S.init(M, DM, G, bx); pg8::EpiCO E{SA, T};
        pg8::gemm_phase<pg8::EpiCO, pg8::StaticOrder, true, true>(lds + RING_OFF, g, S, E); }
    SEAM(6);
    if (IN(7)) { pg8::Gemm g{Ob, Wao, M, DM, DA}; pg8::StaticOrder S; S.init(M, DM, G, bx); pg8::EpiAO E{SBg, T, MIXED};
        pg8::gemm_phase<pg8::EpiAO, pg8::StaticOrder, true, true>(lds + RING_OFF, g, S, E); }
    SEAM(7);
    if (IN(8)) { pg8::Gemm g{MIXED, Wo, M, DM, DM}; pg8::StaticOrder S; S.init(M, DM, G, bx); pg8::EpiDN E{X, X + (size_t)MP * DM, X, 1.0f};
        pg8::gemm_phase<pg8::EpiDN, pg8::StaticOrder, true, true>(lds + RING_OFF, g, S, E); }
    SEAM(8);
    if (IN(9)) { for (int m = gw; m < M; m += NGW) rms_row<false>(X + (size_t)m * DM, g_ffn2, XG + (size_t)m * DM, lane); }
    SEAM(9);
    if (IN(10)) { pg8::Gemm g{XG, Wgu2, M, 2 * DFF, DM}; pg8::StaticOrder S; S.init(M, 2 * DFF, G, bx); pg8::EpiGU E{ACT};
        pg8::gemm_phase<pg8::EpiGU, pg8::StaticOrder, true, true>(lds + RING_OFF, g, S, E); }
    SEAM(10);
    if (IN(11)) { pg8::Gemm g{ACT, Wdn2, M, DM, DFF}; pg8::StaticOrder S; S.init(M, DM, G, bx); pg8::EpiDN E{X, X + (size_t)MP * DM, out + O_Y, 0.5f};
        pg8::gemm_phase<pg8::EpiDN, pg8::StaticOrder, true, true>(lds + RING_OFF, g, S, E); }
    SEAM(11);
    if (IN(12)) { for (int m = gw; m < M; m += NGW) rms_row<true>(out + O_Y + (size_t)m * DM, g_fin, out + O_Y + (size_t)m * DM, lane); }
#undef IN
#undef SEAM
}
#undef x_prompt
#undef x_sample
#undef cache_k
#undef cache_v
#undef state_conv
#undef g_ffn1
#undef w_gu1
#undef w_dn1
#undef g_mix
#undef w_in
#undef conv_w
#undef w_co
#undef w_ao
#undef w_o
#undef g_ffn2
#undef w_gu2
#undef w_dn2
#undef g_fin
#undef out
#undef Wgu1
#undef Wdn1
#undef Win
#undef Wco
#undef Wao
#undef Wo
#undef Wgu2
#undef Wdn2
#undef XN
#undef XG
#undef ACT
#undef X
#undef T
#undef CB
#undef U
#undef Qb
#undef Kb
#undef Vb
#undef Ob
#undef SA
#undef SBg
#undef MIXED
#undef ws

extern "C" void kernel_launch(void* const* d_in, const int* in_sizes, int n_in, void* d_out, int out_size, void* d_ws, size_t ws_size, hipStream_t stream) {
    static int grid = 0;
    if (grid == 0) {
        if (n_in != 18 || in_sizes[0] != MP * DM || (size_t)out_size != O_END || ws_size < WS_END) {
            fprintf(stderr, "kernel_launch: unexpected shapes: n_in %d in0 %d out %d ws %zu (need >= %zu); nothing launched\n", n_in, n_in > 0 ? in_sizes[0] : -1, out_size, ws_size, (size_t)WS_END); grid = -1; return; }
        int dev = 0, cus = 0, per_cu = 0;
        if (hipGetDevice(&dev) != hipSuccess || hipDeviceGetAttribute(&cus, hipDeviceAttributeMultiprocessorCount, dev) != hipSuccess) { grid = -1; return; }
        if (hipFuncSetAttribute((const void*)mk_fwd, hipFuncAttributeMaxDynamicSharedMemorySize, LDS_BYTES) != hipSuccess) { fprintf(stderr, "kernel_launch: hipFuncSetAttribute failed\n"); grid = -1; return; }
        if (hipOccupancyMaxActiveBlocksPerMultiprocessor(&per_cu, (const void*)mk_fwd, NWAVES * 64, LDS_BYTES) != hipSuccess || per_cu < 1) {
            fprintf(stderr, "kernel_launch: occupancy query reports %d workgroups per CU; nothing launched\n", per_cu); (void)hipGetLastError(); grid = -1; return; }
        (void)hipGetLastError();
        grid = cus;
    }
    if (grid < 0) return;
    if (hipMemsetAsync((char*)d_ws + WS_CTL, 0, CTL_ZERO_BYTES, stream) != hipSuccess) return;
    Args a{};
    for (int i = 0; i < 18; ++i) a.in[i] = (const float*)d_in[i];
    a.out = (float*)d_out; a.ws = (unsigned char*)d_ws;
    for (int li = 0; li < N_LAUNCHES; ++li) {
        if (N_LAUNCHES == 1) { a.ph_lo = 0; a.ph_hi = NPHASE; } else { a.ph_lo = li; a.ph_hi = li + 1; }
        a.li = li;
        hipLaunchKernelGGL(mk_fwd, dim3(grid), dim3(NWAVES * 64), LDS_BYTES, stream, a);
    }
}
```

```cpp
#include <hip/hip_runtime.h>
#include <cstdio>
#include <cstdint>

#ifndef MK_N_LAUNCHES
#define MK_N_LAUNCHES 1
#endif

constexpr int DM = 2048, NB = 4, SEQ = 2048, DECB = 16, DECS = 16, PAST = 2048, NH = 8, HD = 128, DA = 1024, DC = 1024, DFF = 5632, DIN = 10240;
constexpr int MP = NB * SEQ, MS = DECB * DECS, M = MP + MS;
constexpr float EPS = 1e-6f;
constexpr float QSCALE = 0.08838834764831845f * 1.4426950408889634f;
constexpr float SB_THRESH = 160.f;

constexpr size_t O_Y = 0, O_KP = (size_t)M * DM, O_VP = O_KP + (size_t)MP * DA, O_CP = O_VP + (size_t)MP * DA, O_KS = O_CP + (size_t)NB * 2 * DC,
                 O_VS = O_KS + (size_t)MS * DA, O_CS = O_VS + (size_t)MS * DA, O_END = O_CS + (size_t)DECB * 2 * DC;

constexpr size_t MiB = 1u << 20;
constexpr size_t WS_CTL = 0, CTL_ZERO_BYTES = 1 * MiB;
constexpr size_t WS_WGU1 = 2 * MiB, WS_WDN1 = 46 * MiB, WS_WIN = 68 * MiB, WS_WCO = 108 * MiB, WS_WAO = 112 * MiB, WS_WO = 116 * MiB, WS_WGU2 = 124 * MiB, WS_WDN2 = 168 * MiB;
constexpr size_t WS_XN = 190 * MiB, WS_XG = 223 * MiB, WS_ACT = 256 * MiB, WS_T = WS_ACT  , WS_X = 347 * MiB;
constexpr size_t HALF_MIB = MiB / 2;
constexpr size_t WS_CB = 413 * MiB, WS_U = WS_CB + 33 * HALF_MIB, WS_Q = WS_U + 33 * HALF_MIB, WS_K = WS_Q + 33 * HALF_MIB, WS_V = WS_K + 33 * HALF_MIB, WS_O = WS_V + 33 * HALF_MIB;
constexpr size_t WS_SA = 512 * MiB, WS_SB = 545 * MiB, WS_MIXED = 578 * MiB, WS_PART = 611 * MiB  , WS_END = 655 * MiB;
static_assert(WS_O + 33 * HALF_MIB <= WS_SA, "ws map");
static_assert((size_t)M * DFF * 2 <= 91 * MiB && (size_t)M * DM * 4 == 66 * MiB && (size_t)M * DA * 2 == 33 * HALF_MIB, "ws sizes");

constexpr int CW_TMO = 0, CW_CODE = 1, CW_BAR = 4096;

namespace pg8 {
#define PG8_LAS __attribute__((address_space(3)))
typedef unsigned short bf16_t;
typedef short bf16x8 __attribute__((ext_vector_type(8)));
typedef float f32x4 __attribute__((ext_vector_type(4)));
typedef unsigned u32x4 __attribute__((ext_vector_type(4)));
constexpr int BM = 256, BK = 64, HALF = 128, HTB = HALF * BK * 2, STAGE_BYTES = 8 * HTB, NXCD = 8, WGM = 8;

__host__ __device__ __forceinline__ int lds_byte(int r, int c) { const int st = (r >> 4) * 2 + (c >> 5), rr = r & 15, cc = c & 31, ob = rr * 64 + cc * 2; return st * 1024 + (ob ^ (((ob >> 9) & 1) << 5)); }
__host__ __device__ __forceinline__ void stage_rc(int b, int& R, int& C) { const int st = b / 1024, sb = b % 1024, swz = sb ^ (((sb >> 9) & 1) << 5); R = (st >> 1) * 16 + swz / 64; C = (st & 1) * 32 + (swz % 64) / 2; }
__host__ __device__ __forceinline__ int perm32(int rho) { const int n = rho >> 4, i = rho & 15; return 8 * (i >> 2) + 4 * n + (i & 3); }

struct Unit { int pm, pn, ks, k0, nt; };
struct Gemm { const bf16_t* A; const bf16_t* Bt; int M, N, K; };

struct StaticOrder {
    int nM, nN, nwg, G, c, knt;
    __host__ __device__ void init(int M_, int N_, int G_, int c_, int K_) { nM = M_ / BM; nN = N_ / BM; nwg = nM * nN; G = G_; c = c_; knt = K_ / BK; }
    __host__ __device__ bool next(int i, Unit& u) const {
        const long L = (long)i * G + c; if (L >= nwg) return false;
        int wgid = (int)L; { const int q = nwg / NXCD, r = nwg % NXCD, xcd = wgid % NXCD, off = wgid / NXCD; wgid = (xcd < r ? xcd * (q + 1) : r * (q + 1) + (xcd - r) * q) + off; }
        const int nig = WGM * nN, gid = wgid / nig, fm = gid * WGM, gsz = (nM - fm) < WGM ? (nM - fm) : WGM;
        u.pm = fm + ((wgid % nig) % gsz); u.pn = (wgid % nig) / gsz; u.ks = -1; u.k0 = 0; u.nt = knt; return true;
    }
    __device__ __forceinline__ void a_ready(const Unit&) const {}
    __device__ __forceinline__ void done(const Unit&) const {}
};
struct SkOrder {
    StaticOrder base; int nslice, slice_nt, npiece;
    __host__ __device__ void init(int G_, int c_, int K_, int slice_nt_) { base.init(MP, DM, G_, c_, K_); slice_nt = slice_nt_; nslice = (K_ / BK) / slice_nt_; npiece = nslice * (DM / BM); }
    __host__ __device__ bool next(int i, Unit& u) const {
        const long L = (long)i * base.G + base.c;
        if (L < base.nwg) return base.next(i, u);
        const int p = (int)(L - base.nwg); if (p >= npiece) return false;
        u.pm = MP / BM; u.pn = p % (DM / BM); u.ks = p / (DM / BM); u.k0 = u.ks * slice_nt * BK; u.nt = slice_nt; return true;
    }
    __device__ __forceinline__ void a_ready(const Unit&) const {}
    __device__ __forceinline__ void done(const Unit&) const {}
};

typedef float f32x2_t __attribute__((ext_vector_type(2))); typedef __bf16 bf16x2_t __attribute__((ext_vector_type(2)));
__device__ __forceinline__ unsigned cvt_pk_bf16(float lo, float hi) { f32x2_t v = {lo, hi}; bf16x2_t b = __builtin_convertvector(v, bf16x2_t); return __builtin_bit_cast(unsigned, b); }
__device__ __forceinline__ u32x4 pack8(const f32x4 a, const f32x4 b) { u32x4 w; w.x = cvt_pk_bf16(a[0], a[1]); w.y = cvt_pk_bf16(a[2], a[3]); w.z = cvt_pk_bf16(b[0], b[1]); w.w = cvt_pk_bf16(b[2], b[3]); return w; }
__device__ __forceinline__ float bf_lo(unsigned w) { return __uint_as_float(w << 16); }
__device__ __forceinline__ float bf_hi(unsigned w) { return __uint_as_float(w & 0xffff0000u); }
__device__ __forceinline__ float sigmoidf_(float x) { return __builtin_amdgcn_rcpf(1.0f + __builtin_amdgcn_exp2f(-1.4426950408889634f * x)); }


struct EpiGU {
    static constexpr bool PERM = true, AFTER_DRAIN = false;
    bf16_t* act;
    __device__ __forceinline__ void operator()(const f32x4 (&acc)[2][2][4][2], const Unit& u, int wr, int wc, int fr, int fq) const {
        const int row0 = u.pm * BM + wr * 64 + fr, f0 = u.pn * HALF + wc * 32 + 8 * fq;
#pragma unroll
        for (int ai = 0; ai < 2; ++ai)
#pragma unroll
            for (int m = 0; m < 4; ++m) {
                f32x4 o[2];
#pragma unroll
                for (int n = 0; n < 2; ++n)
#pragma unroll
                    for (int j = 0; j < 4; ++j) { const float g = acc[ai][0][m][n][j], uu = acc[ai][1][m][n][j]; o[n][j] = g * uu * sigmoidf_(g); }
                *(u32x4*)(act + (size_t)(row0 + ai * HALF + m * 16) * DFF + f0) = pack8(o[0], o[1]);
            }
    }
};
struct EpiDN {
    static constexpr bool PERM = false, AFTER_DRAIN = false;
    const float* res_p; const float* res_s; float* out; float scale; float* part;
    __device__ __forceinline__ void operator()(const f32x4 (&acc)[2][2][4][2], const Unit& u, int wr, int wc, int fr, int fq) const {
        const int row0 = u.pm * BM + wr * 64 + fr, col0 = u.pn * BM + wc * 32 + 4 * fq;
        if (u.ks >= 0) {
            float* pb = part + ((size_t)u.ks * BM + wr * 64 + fr) * DM + col0;
#pragma unroll
            for (int ai = 0; ai < 2; ++ai)
#pragma unroll
                for (int m = 0; m < 4; ++m)
#pragma unroll
                    for (int bj = 0; bj < 2; ++bj)
#pragma unroll
                        for (int n = 0; n < 2; ++n) *(f32x4*)(pb + (size_t)(ai * HALF + m * 16) * DM + bj * HALF + n * 16) = acc[ai][bj][m][n];
            return;
        }
        const float* rbase = (u.pm < MP / BM) ? res_p : (res_s - (size_t)MP * DM);
#pragma unroll
        for (int ai = 0; ai < 2; ++ai)
#pragma unroll
            for (int m = 0; m < 4; ++m) { const size_t off = (size_t)(row0 + ai * HALF + m * 16) * DM + col0;
                f32x4 rv[2][2];
#pragma unroll
                for (int bj = 0; bj < 2; ++bj)
#pragma unroll
                    for (int n = 0; n < 2; ++n) rv[bj][n] = *(const f32x4*)(rbase + off + bj * HALF + n * 16);
#pragma unroll
                for (int bj = 0; bj < 2; ++bj)
#pragma unroll
                    for (int n = 0; n < 2; ++n) *(f32x4*)(out + off + bj * HALF + n * 16) = rv[bj][n] + acc[ai][bj][m][n] * scale;
            }
    }
};
struct EpiIN {
    static constexpr bool PERM = true, AFTER_DRAIN = false;
    bf16_t *cb, *uu, *q, *k, *v, *sa, *sb; float* dout;
    __device__ __forceinline__ void operator()(const f32x4 (&acc)[2][2][4][2], const Unit& u, int wr, int wc, int fr, int fq) const {
        const int row0 = u.pm * BM + wr * 64 + fr; const int pn = u.pn; const bool prompt = u.pm < MP / BM;
        if (pn >= 4 && pn < 12) {
            const int c8 = (pn - 4) * HALF + wc * 32 + 8 * fq;
#pragma unroll
            for (int ai = 0; ai < 2; ++ai)
#pragma unroll
                for (int m = 0; m < 4; ++m) { const int row = row0 + ai * HALF + m * 16;
                    const f32x4 o0 = acc[ai][0][m][0] * acc[ai][1][m][0], o1 = acc[ai][0][m][1] * acc[ai][1][m][1];
                    *(u32x4*)(uu + (size_t)row * DC + c8) = pack8(o0, o1);
                    if (fr >= 14) {
                        float* dst = nullptr;
                        if (prompt) { if ((u.pm & 7) == 7 && ai == 1 && wr == 1 && m == 3) dst = dout + O_CP + ((size_t)((u.pm >> 3) * 2 + (fr - 14)) * DC + c8); }
                        else dst = dout + O_CS + ((size_t)((8 * ai + 4 * wr + m) * 2 + (fr - 14)) * DC + c8);
                        if (dst) { *(f32x4*)dst = o0; *(f32x4*)(dst + 4) = o1; }
                    }
                }
            return;
        }
        if (pn >= 16 && pn < 24) {
            const bool isk = pn < 20; const int tcol = (isk ? pn - 16 : pn - 20) * BM + wc * 32 + 8 * fq;
            bf16_t* wsb = isk ? k : v;
            float* ob = dout + (prompt ? (isk ? O_KP : O_VP) : (isk ? O_KS : O_VS) - (size_t)MP * DA);
#pragma unroll
            for (int ai = 0; ai < 2; ++ai)
#pragma unroll
                for (int m = 0; m < 4; ++m) { const size_t off = (size_t)(row0 + ai * HALF + m * 16) * DA + tcol;
#pragma unroll
                    for (int bj = 0; bj < 2; ++bj) { const f32x4 v0 = acc[ai][bj][m][0], v1 = acc[ai][bj][m][1];
                        *(f32x4*)(ob + off + bj * HALF) = v0; *(f32x4*)(ob + off + bj * HALF + 4) = v1;
                        *(u32x4*)(wsb + off + bj * HALF) = pack8(v0, v1); } }
            return;
        }
        if (pn >= 24) {
            const bool isa = pn < 32; const int tcol = (isa ? pn - 24 : pn - 32) * BM + wc * 32 + 8 * fq; bf16_t* wsb = isa ? sa : sb;
#pragma unroll
            for (int ai = 0; ai < 2; ++ai)
#pragma unroll
                for (int m = 0; m < 4; ++m) { const size_t off = (size_t)(row0 + ai * HALF + m * 16) * DM + tcol;
#pragma unroll
                    for (int bj = 0; bj < 2; ++bj) { f32x4 v0 = acc[ai][bj][m][0], v1 = acc[ai][bj][m][1];
#pragma unroll
                        for (int j = 0; j < 4; ++j) { v0[j] = sigmoidf_(v0[j]); v1[j] = sigmoidf_(v1[j]); }
                        *(u32x4*)(wsb + off + bj * HALF) = pack8(v0, v1); } }
            return;
        }
        {
            const bool isq = pn >= 12; const int tcol = (isq ? pn - 12 : pn) * BM + wc * 32 + 8 * fq; bf16_t* wsb = isq ? q : cb; const float sc = isq ? QSCALE : 1.0f;
#pragma unroll
            for (int ai = 0; ai < 2; ++ai)
#pragma unroll
                for (int m = 0; m < 4; ++m) { const size_t off = (size_t)(row0 + ai * HALF + m * 16) * DA + tcol;
#pragma unroll
                    for (int bj = 0; bj < 2; ++bj) *(u32x4*)(wsb + off + bj * HALF) = pack8(acc[ai][bj][m][0] * sc, acc[ai][bj][m][1] * sc); }
        }
    }
};
struct EpiCO {
    static constexpr bool PERM = true, AFTER_DRAIN = false;
    const bf16_t* sa; float* t;
    __device__ __forceinline__ void operator()(const f32x4 (&acc)[2][2][4][2], const Unit& u, int wr, int wc, int fr, int fq) const {
        const int row0 = u.pm * BM + wr * 64 + fr, col0 = u.pn * BM + wc * 32 + 8 * fq;
#pragma unroll
        for (int ai = 0; ai < 2; ++ai)
#pragma unroll
            for (int m = 0; m < 4; ++m) { const size_t off = (size_t)(row0 + ai * HALF + m * 16) * DM + col0;
                u32x4 g[2];
#pragma unroll
                for (int bj = 0; bj < 2; ++bj) g[bj] = *(const u32x4*)(sa + off + bj * HALF);
#pragma unroll
                for (int bj = 0; bj < 2; ++bj) { const f32x4 a0 = acc[ai][bj][m][0], a1 = acc[ai][bj][m][1];
                    f32x4 o0, o1; o0[0] = a0[0] * bf_lo(g[bj].x); o0[1] = a0[1] * bf_hi(g[bj].x); o0[2] = a0[2] * bf_lo(g[bj].y); o0[3] = a0[3] * bf_hi(g[bj].y);
                    o1[0] = a1[0] * bf_lo(g[bj].z); o1[1] = a1[1] * bf_hi(g[bj].z); o1[2] = a1[2] * bf_lo(g[bj].w); o1[3] = a1[3] * bf_hi(g[bj].w);
                    *(f32x4*)(t + off + bj * HALF) = o0; *(f32x4*)(t + off + bj * HALF + 4) = o1; } }
    }
};
struct EpiAO {
    static constexpr bool PERM = true, AFTER_DRAIN = false;
    const bf16_t* sb; const float* t; bf16_t* mixed;
    __device__ __forceinline__ void operator()(const f32x4 (&acc)[2][2][4][2], const Unit& u, int wr, int wc, int fr, int fq) const {
        const int row0 = u.pm * BM + wr * 64 + fr, col0 = u.pn * BM + wc * 32 + 8 * fq;
#pragma unroll
        for (int ai = 0; ai < 2; ++ai)
#pragma unroll
            for (int m = 0; m < 4; ++m) { const size_t off = (size_t)(row0 + ai * HALF + m * 16) * DM + col0;
                u32x4 g[2]; f32x4 tv[2][2];
#pragma unroll
                for (int bj = 0; bj < 2; ++bj) { g[bj] = *(const u32x4*)(sb + off + bj * HALF); tv[bj][0] = *(const f32x4*)(t + off + bj * HALF); tv[bj][1] = *(const f32x4*)(t + off + bj * HALF + 4); }
#pragma unroll
                for (int bj = 0; bj < 2; ++bj) { const f32x4 a0 = acc[ai][bj][m][0], a1 = acc[ai][bj][m][1];
                    f32x4 o0, o1; o0[0] = a0[0] * bf_lo(g[bj].x); o0[1] = a0[1] * bf_hi(g[bj].x); o0[2] = a0[2] * bf_lo(g[bj].y); o0[3] = a0[3] * bf_hi(g[bj].y);
                    o1[0] = a1[0] * bf_lo(g[bj].z); o1[1] = a1[1] * bf_hi(g[bj].z); o1[2] = a1[2] * bf_lo(g[bj].w); o1[3] = a1[3] * bf_hi(g[bj].w);
                    *(u32x4*)(mixed + off + bj * HALF) = pack8(o0 + tv[bj][0], o1 + tv[bj][1]); } }
    }
};

template <class Epi, class Sched, bool ALIGN_EPI = false, bool SP2 = false>
__device__ __forceinline__ void gemm_phase(PG8_LAS unsigned char* lds, const Gemm g, const Sched& S, const Epi& E) {
    const int tid = threadIdx.x, wid = __builtin_amdgcn_readfirstlane(tid >> 6), lane = tid & 63, wr = wid >> 2, wc = wid & 3, fr = lane & 15, fq = lane >> 4;
    const int K = g.K;
    unsigned voffA[2], voffB[2];
#pragma unroll
    for (int i = 0; i < 2; ++i) { int R, C; stage_rc(tid * 16 + i * 8192, R, C); const int Rb = Epi::PERM ? ((R & ~31) + perm32(R & 31)) : R;
        voffA[i] = (unsigned)(R * K + C) * 2u; voffB[i] = (unsigned)(Rb * K + C) * 2u; }
    const size_t kstep = (size_t)(BK * 2);
    const size_t hstep = (size_t)HALF * K * 2;
    const size_t tstep = 2 * hstep;
    const unsigned ldsw = (unsigned)wid * 1024u;
    const int aoff = lds_byte(wr * 64 + fr, fq * 8), boff = lds_byte(wc * 32 + fr, fq * 8);
#define PG8_SA(b, h) (((b) * 2 + (h)) * HTB)
#define PG8_SB(b, h) ((4 + (b) * 2 + (h)) * HTB)
#define PG8_STAGE(bufoff, gbase, voff) do { _Pragma("unroll") for (int _i = 0; _i < 2; ++_i) \
        __builtin_amdgcn_global_load_lds((const unsigned*)((const char*)(gbase) + (voff)[_i]), (PG8_LAS unsigned*)(lds + (bufoff) + ldsw + _i * 8192), 16, 0, 0); } while (0)
#define PG8_LDA(dst, b, h) do { _Pragma("unroll") for (int m = 0; m < 4; ++m) _Pragma("unroll") for (int k = 0; k < 2; ++k) dst[m][k] = *(const PG8_LAS bf16x8*)(lds + PG8_SA(b, h) + aoff + m * 2048 + k * 1024); } while (0)
#define PG8_LDB(dst, b, h) do { _Pragma("unroll") for (int n = 0; n < 2; ++n) _Pragma("unroll") for (int k = 0; k < 2; ++k) dst[n][k] = *(const PG8_LAS bf16x8*)(lds + PG8_SB(b, h) + boff + n * 2048 + k * 1024); } while (0)
#define PG8_MMA(ai, bj, At, Bt) do { __builtin_amdgcn_s_setprio(1); _Pragma("unroll") for (int m = 0; m < 4; ++m) _Pragma("unroll") for (int n = 0; n < 2; ++n) _Pragma("unroll") for (int k = 0; k < 2; ++k) \
        acc[ai][bj][m][n] = __builtin_amdgcn_mfma_f32_16x16x32_bf16(Bt[n][k], At[m][k], acc[ai][bj][m][n], 0, 0, 0); __builtin_amdgcn_s_setprio(0); } while (0)
#define PG8_WAIT_V(n) asm volatile("s_waitcnt vmcnt(" #n ")" ::: "memory")
#define PG8_WAIT_L(n) asm volatile("s_waitcnt lgkmcnt(" #n ")" ::: "memory")
#define PG8_BAR __builtin_amdgcn_s_barrier()
#define PG8_SCHED __builtin_amdgcn_sched_barrier(0)
    Unit cur, nxt; int ui = 0;
    if (!S.next(0, cur)) return;
    f32x4 acc[2][2][4][2];
#pragma unroll
    for (int a = 0; a < 2; ++a)
#pragma unroll
        for (int b = 0; b < 2; ++b)
#pragma unroll
            for (int m = 0; m < 4; ++m)
#pragma unroll
                for (int n = 0; n < 2; ++n) acc[a][b][m][n] = (f32x4){0.f, 0.f, 0.f, 0.f};
    bf16x8 At[4][2], B0[2][2], B1[2][2];
    const char* cA = (const char*)g.A + (size_t)cur.pm * tstep + (size_t)cur.k0 * 2; const char* cB = (const char*)g.Bt + (size_t)cur.pn * tstep + (size_t)cur.k0 * 2;
    S.a_ready(cur);
    if constexpr (SP2) {
        PG8_STAGE(PG8_SB(0, 0), cB, voffB); PG8_STAGE(PG8_SB(0, 1), cB + hstep, voffB); PG8_STAGE(PG8_SA(0, 0), cA, voffA); PG8_STAGE(PG8_SA(0, 1), cA + hstep, voffA);
        if (wr == 1) PG8_BAR;
        PG8_WAIT_V(2); PG8_BAR;
        PG8_STAGE(PG8_SB(1, 0), cB + kstep, voffB); PG8_STAGE(PG8_SA(1, 0), cA + kstep, voffA); PG8_STAGE(PG8_SB(1, 1), cB + hstep + kstep, voffB);
        PG8_WAIT_V(6); PG8_BAR;
    } else {
        PG8_STAGE(PG8_SB(0, 0), cB, voffB); PG8_STAGE(PG8_SA(0, 0), cA, voffA); PG8_STAGE(PG8_SB(0, 1), cB + hstep, voffB); PG8_STAGE(PG8_SA(0, 1), cA + hstep, voffA);
        if (wr == 1) PG8_BAR;
        PG8_WAIT_V(4); PG8_BAR;
        PG8_STAGE(PG8_SB(1, 0), cB + kstep, voffB); PG8_STAGE(PG8_SA(1, 0), cA + kstep, voffA); PG8_STAGE(PG8_SB(1, 1), cB + hstep + kstep, voffB);
        PG8_WAIT_V(6); PG8_BAR;
    }
    for (;;) {
        const bool has_next = S.next(ui + 1, nxt);
        const char* nA = has_next ? (const char*)g.A + (size_t)nxt.pm * tstep + (size_t)nxt.k0 * 2 : cA; const char* nB = has_next ? (const char*)g.Bt + (size_t)nxt.pn * tstep + (size_t)nxt.k0 * 2 : cB;
        const int nt = cur.nt;
        for (int t = 0; t < nt; t += 2) {
            const bool last = (t == nt - 2);
            const char* a1 = cA + (size_t)(t + 1) * kstep;
            const char* a2 = last ? nA : cA + (size_t)(t + 2) * kstep; const char* b2 = last ? nB : cB + (size_t)(t + 2) * kstep;
            const char* a3 = a2 + kstep; const char* b3 = b2 + kstep;
            if (last && has_next) S.a_ready(nxt);
            if constexpr (SP2) {
            PG8_LDB(B0, 0, 0); PG8_LDB(B1, 0, 1); PG8_SCHED; PG8_LDA(At, 0, 0); PG8_STAGE(PG8_SA(1, 1), a1 + hstep, voffA);
            PG8_WAIT_V(8); PG8_WAIT_L(0); PG8_BAR; PG8_MMA(0, 0, At, B0); PG8_MMA(0, 1, At, B1); PG8_BAR; PG8_SCHED;
            PG8_LDA(At, 0, 1); PG8_STAGE(PG8_SB(0, 0), b2, voffB); PG8_STAGE(PG8_SB(0, 1), b2 + hstep, voffB); PG8_STAGE(PG8_SA(0, 0), a2, voffA);
            PG8_WAIT_V(8); PG8_WAIT_L(0); PG8_BAR; PG8_MMA(1, 0, At, B0); PG8_MMA(1, 1, At, B1); PG8_BAR; PG8_SCHED;
            PG8_LDB(B0, 1, 0); PG8_LDB(B1, 1, 1); PG8_SCHED; PG8_LDA(At, 1, 0); PG8_STAGE(PG8_SA(0, 1), a2 + hstep, voffA);
            PG8_WAIT_V(8); PG8_WAIT_L(0); PG8_BAR; PG8_MMA(0, 0, At, B0); PG8_MMA(0, 1, At, B1); PG8_BAR; PG8_SCHED;
            PG8_LDA(At, 1, 1); PG8_STAGE(PG8_SB(1, 0), b3, voffB); PG8_STAGE(PG8_SB(1, 1), b3 + hstep, voffB); PG8_STAGE(PG8_SA(1, 0), a3, voffA);
            PG8_WAIT_V(8); PG8_WAIT_L(0); PG8_BAR; PG8_MMA(1, 0, At, B0); PG8_MMA(1, 1, At, B1); PG8_BAR; PG8_SCHED;
            } else {
            PG8_LDB(B0, 0, 0); PG8_SCHED; PG8_LDA(At, 0, 0); PG8_STAGE(PG8_SA(1, 1), a1 + hstep, voffA);
            PG8_WAIT_L(8); PG8_BAR; PG8_WAIT_L(0); PG8_MMA(0, 0, At, B0); PG8_BAR; PG8_SCHED;
            PG8_LDB(B1, 0, 1); PG8_STAGE(PG8_SB(0, 0), b2, voffB);
            PG8_BAR; PG8_WAIT_L(0); PG8_MMA(0, 1, At, B1); PG8_BAR;
            PG8_LDA(At, 0, 1); PG8_STAGE(PG8_SA(0, 0), a2, voffA);
            PG8_BAR; PG8_WAIT_L(0); PG8_MMA(1, 0, At, B0); PG8_BAR; PG8_SCHED;
            PG8_STAGE(PG8_SB(0, 1), b2 + hstep, voffB);
            PG8_WAIT_V(6); PG8_BAR; PG8_MMA(1, 1, At, B1); PG8_BAR;
            PG8_LDB(B0, 1, 0); PG8_SCHED; PG8_LDA(At, 1, 0); PG8_STAGE(PG8_SA(0, 1), a2 + hstep, voffA);
            PG8_WAIT_L(8); PG8_BAR; PG8_WAIT_L(0); PG8_MMA(0, 0, At, B0); PG8_BAR; PG8_SCHED;
            PG8_LDB(B1, 1, 1); PG8_STAGE(PG8_SB(1, 0), b3, voffB);
            PG8_BAR; PG8_WAIT_L(0); PG8_MMA(0, 1, At, B1); PG8_BAR;
            PG8_LDA(At, 1, 1); PG8_STAGE(PG8_SA(1, 0), a3, voffA);
            PG8_BAR; PG8_WAIT_L(0); PG8_MMA(1, 0, At, B0); PG8_BAR; PG8_SCHED;
            PG8_STAGE(PG8_SB(1, 1), b3 + hstep, voffB);
            PG8_WAIT_V(6); PG8_BAR; PG8_MMA(1, 1, At, B1); PG8_BAR;
            }
        }
        if constexpr (ALIGN_EPI) { if (wr == 0) PG8_BAR; }
        if constexpr (!Epi::AFTER_DRAIN) { E(acc, cur, wr, wc, fr, fq); S.done(cur); }
        if (!has_next) break;
#pragma unroll
        for (int a = 0; a < 2; ++a)
#pragma unroll
            for (int b = 0; b < 2; ++b)
#pragma unroll
                for (int m = 0; m < 4; ++m)
#pragma unroll
                    for (int n = 0; n < 2; ++n) acc[a][b][m][n] = (f32x4){0.f, 0.f, 0.f, 0.f};
        cur = nxt; cA = nA; cB = nB; ++ui;
        if constexpr (ALIGN_EPI) { if (wr == 1) PG8_BAR; }
    }
    PG8_WAIT_V(0);
    if constexpr (!ALIGN_EPI) { if (wr == 0) PG8_BAR; }
    PG8_BAR;
#undef PG8_SA
#undef PG8_SB
#undef PG8_STAGE
#undef PG8_LDA
#undef PG8_LDB
#undef PG8_MMA
#undef PG8_WAIT_V
#undef PG8_WAIT_L
#undef PG8_BAR
#undef PG8_SCHED
}
}

namespace sba {
#define LAS __attribute__((address_space(3)))
typedef unsigned short bf16_t;
typedef short bf16x8 __attribute__((ext_vector_type(8)));
typedef short s16x4 __attribute__((ext_vector_type(4)));
typedef float f32x16 __attribute__((ext_vector_type(16)));
typedef float f32x4 __attribute__((ext_vector_type(4)));
typedef unsigned u32x4 __attribute__((ext_vector_type(4)));
typedef unsigned u32x2 __attribute__((ext_vector_type(2)));
#define SBAR() __builtin_amdgcn_sched_barrier(0)
#define KSWZ(row, colB) ((row) * 256 + ((colB) ^ (((row) & 7) << 4)))
constexpr int L_K = 0, L_V = 32768, L_Q = 65536, L_FLAGS = 131072 + 1024, L_RTAB = 131072 + 2048, L_OBUF = 0, TILE_B = 16384;
__device__ __forceinline__ int crow(int r, int hi) { return (r & 3) + 8 * (r >> 2) + 4 * hi; }
__device__ __forceinline__ unsigned cvtpk(float lo, float hi) { return pg8::cvt_pk_bf16(lo, hi); }
__device__ __forceinline__ int v_st(int k, int c) { return (c >> 5) * 4096 + (k >> 3) * 512 + (k & 7) * 64 + (c & 31) * 2; }
__device__ __forceinline__ int v_rd_base(int lane) { return ((lane >> 4) & 1) * 32 + (lane & 3) * 8 + (4 * (lane >> 5) + ((lane & 15) >> 2)) * 64; }
template <int OFF> __device__ __forceinline__ s16x4 tr_read(unsigned vb) { s16x4 r; asm volatile("ds_read_b64_tr_b16 %0, %1 offset:%2" : "=&v"(r) : "v"(vb), "i"(OFF) : "memory"); return r; }

template <bool MASK> __device__ __forceinline__ void sb_block(f32x16& p, float& carry, int kbase, int qpos, int hi) {
    float sp[16];
#pragma unroll
    for (int r = 0; r < 16; ++r) { const float z = p[r]; const float t = __builtin_amdgcn_exp2f(-__builtin_fabsf(z)); const float l = __builtin_amdgcn_logf(1.0f + t);
        sp[r] = __builtin_fmaxf(z, 0.f) + l;
        if (MASK) { if (!(kbase + crow(r, hi) < qpos)) { sp[r] = 0.f; p[r] = -__builtin_inff(); } } }
    float Gp[4], T[4];
#pragma unroll
    for (int g = 0; g < 4; ++g) { const float G = (sp[4 * g] + sp[4 * g + 1]) + (sp[4 * g + 2] + sp[4 * g + 3]);
        auto rr = __builtin_amdgcn_permlane32_swap(__float_as_uint(G), __float_as_uint(G), false, false);
        const float glo = __uint_as_float(rr[0]), ghi = __uint_as_float(rr[1]);
        T[g] = glo + ghi; Gp[g] = hi ? 0.f : ghi; }
    float st = carry;
#pragma unroll
    for (int g = 3; g >= 0; --g) {
        const float base = st + Gp[g];
        const float t3 = base + sp[4 * g + 3], t2 = t3 + sp[4 * g + 2], t1 = t2 + sp[4 * g + 1], t0 = t1 + sp[4 * g + 0];
        p[4 * g + 3] = __builtin_amdgcn_exp2f(p[4 * g + 3] - t3); p[4 * g + 2] = __builtin_amdgcn_exp2f(p[4 * g + 2] - t2);
        p[4 * g + 1] = __builtin_amdgcn_exp2f(p[4 * g + 1] - t1); p[4 * g + 0] = __builtin_amdgcn_exp2f(p[4 * g + 0] - t0);
        st += T[g];
    }
    carry = st;
}
template <bool MASK> __device__ __forceinline__ float sb_part1(f32x16& p, float (&sp)[16], float (&Gp)[4], float (&T)[4], int hi, int q) {
#pragma unroll
    for (int r = 0; r < 16; ++r) { const float z = p[r]; const float t = __builtin_amdgcn_exp2f(-__builtin_fabsf(z)); const float l = __builtin_amdgcn_logf(1.0f + t);
        sp[r] = __builtin_fmaxf(z, 0.f) + l;
        if (MASK) { if (!(crow(r, hi) < q)) { sp[r] = 0.f; p[r] = -__builtin_inff(); } } }
    float tot = 0.f;
#pragma unroll
    for (int g = 0; g < 4; ++g) { const float G = (sp[4 * g] + sp[4 * g + 1]) + (sp[4 * g + 2] + sp[4 * g + 3]);
        auto rr = __builtin_amdgcn_permlane32_swap(__float_as_uint(G), __float_as_uint(G), false, false);
        const float glo = __uint_as_float(rr[0]), ghi = __uint_as_float(rr[1]);
        T[g] = glo + ghi; Gp[g] = hi ? 0.f : ghi; tot += T[g]; }
    return tot;
}
__device__ __forceinline__ void sb_part2(f32x16& p, const float (&sp)[16], const float (&Gp)[4], const float (&T)[4], float carry) {
    float st = carry;
#pragma unroll
    for (int g = 3; g >= 0; --g) {
        const float base = st + Gp[g];
        const float t3 = base + sp[4 * g + 3], t2 = t3 + sp[4 * g + 2], t1 = t2 + sp[4 * g + 1], t0 = t1 + sp[4 * g + 0];
        p[4 * g + 3] = __builtin_amdgcn_exp2f(p[4 * g + 3] - t3); p[4 * g + 2] = __builtin_amdgcn_exp2f(p[4 * g + 2] - t2);
        p[4 * g + 1] = __builtin_amdgcn_exp2f(p[4 * g + 1] - t1); p[4 * g + 0] = __builtin_amdgcn_exp2f(p[4 * g + 0] - t0);
        st += T[g];
    }
}
#define PK8(P, B) (u32x4){cvtpk(P[B], P[B + 1]), cvtpk(P[B + 2], P[B + 3]), cvtpk(P[B + 4], P[B + 5]), cvtpk(P[B + 6], P[B + 7])}

template <int D0> __device__ __forceinline__ void pv_one(f32x16& od, unsigned vb, bf16x8 pa0, bf16x8 pa1, bf16x8 pa2, bf16x8 pa3) {
    const s16x4 l0 = tr_read<D0 * 4096 + 0 * 1024>(vb), h0 = tr_read<D0 * 4096 + 0 * 1024 + 512>(vb), l1 = tr_read<D0 * 4096 + 1 * 1024>(vb), h1 = tr_read<D0 * 4096 + 1 * 1024 + 512>(vb);
    const s16x4 l2 = tr_read<D0 * 4096 + 2 * 1024>(vb), h2 = tr_read<D0 * 4096 + 2 * 1024 + 512>(vb), l3 = tr_read<D0 * 4096 + 3 * 1024>(vb), h3 = tr_read<D0 * 4096 + 3 * 1024 + 512>(vb);
    asm volatile("s_waitcnt lgkmcnt(0)" ::: "memory"); SBAR();
#define PKV(L, H) (bf16x8){L[0], L[1], L[2], L[3], H[0], H[1], H[2], H[3]}
    od = __builtin_amdgcn_mfma_f32_32x32x16_bf16(pa0, PKV(l0, h0), od, 0, 0, 0);
    od = __builtin_amdgcn_mfma_f32_32x32x16_bf16(pa1, PKV(l1, h1), od, 0, 0, 0);
    od = __builtin_amdgcn_mfma_f32_32x32x16_bf16(pa2, PKV(l2, h2), od, 0, 0, 0);
    od = __builtin_amdgcn_mfma_f32_32x32x16_bf16(pa3, PKV(l3, h3), od, 0, 0, 0);
#undef PKV
}

__device__ __forceinline__ void prompt_unit(int b, int h, int qb, const bf16_t* Q, const bf16_t* Kg, const bf16_t* Vg, bf16_t* O, LAS unsigned char* lds) {
    const int tid = threadIdx.x, lane = tid & 63, r32 = lane & 31, hi = lane >> 5; const int wid = __builtin_amdgcn_readfirstlane(tid >> 6);
    const size_t rowbase = (size_t)b * SEQ; const int qw0 = 256 * qb + 32 * wid;
    const bf16_t* Kh = Kg + rowbase * DA + h * HD; const bf16_t* Vh = Vg + rowbase * DA + h * HD;
    LAS unsigned char* Ql = lds + L_Q + wid * 8192 + lane * 16;
    { const bf16_t* Qw = Q + (rowbase + qw0 + r32) * DA + h * HD + hi * 8;
#pragma unroll
      for (int d0 = 0; d0 < 8; ++d0) *(LAS bf16x8*)(Ql + d0 * 1024) = *(const bf16x8*)(Qw + d0 * 16); }
    const int krow0 = 4 * wid + (lane >> 4), krow1 = krow0 + 32;
    const bf16_t* ksrc0 = Kh + (size_t)krow0 * DA + (((lane & 15) ^ (krow0 & 7)) * 8);
    const bf16_t* ksrc1 = Kh + (size_t)krow1 * DA + (((lane & 15) ^ (krow1 & 7)) * 8);
    const bf16_t* vsrc0 = Vh + (size_t)(16 * (wid & 3) + (lane >> 2)) * DA + (wid >> 2) * 32 + (lane & 3) * 8;
    const bf16_t* vsrc1 = vsrc0 + 64;
    const unsigned vb0 = (unsigned)(uintptr_t)(lds + L_V) + (unsigned)v_rd_base(lane);
    LAS unsigned* flags = (LAS unsigned*)(lds + L_FLAGS);
#define SLOAD(k0, bb) do { const size_t go_ = (size_t)(k0) * DA; \
        __builtin_amdgcn_global_load_lds((const unsigned*)(ksrc0 + go_), (LAS unsigned*)(lds + L_K + (bb) * TILE_B + wid * 1024), 16, 0, 0); \
        __builtin_amdgcn_global_load_lds((const unsigned*)(ksrc1 + go_), (LAS unsigned*)(lds + L_K + (bb) * TILE_B + (wid + 8) * 1024), 16, 0, 0); \
        __builtin_amdgcn_global_load_lds((const unsigned*)(vsrc0 + go_), (LAS unsigned*)(lds + L_V + (bb) * TILE_B + wid * 1024), 16, 0, 0); \
        __builtin_amdgcn_global_load_lds((const unsigned*)(vsrc1 + go_), (LAS unsigned*)(lds + L_V + (bb) * TILE_B + (wid + 8) * 1024), 16, 0, 0); } while (0)
    const int NT = 4 * qb + 4;
    f32x16 o[4]; o[0] = f32x16{}; o[1] = f32x16{}; o[2] = f32x16{}; o[3] = f32x16{};
    float carry = 0.f; bool wdone = false; const int qpos = qw0 + r32;
    SLOAD(64 * (NT - 1), 0); asm volatile("s_waitcnt vmcnt(0)" ::: "memory"); __syncthreads();
    for (int it = 0; it < NT; ++it) {
        const int jt = NT - 1 - it, bb = it & 1, k0 = 64 * jt; const bool have_next = jt > 0;
        if (have_next) SLOAD(64 * (jt - 1), bb ^ 1);
        if (!wdone && k0 <= qw0) {
            f32x16 p0 = f32x16{}, p1 = f32x16{};
            const LAS unsigned char* Kb = lds + L_K + bb * TILE_B;
#pragma unroll
            for (int d0 = 0; d0 < 8; ++d0) { const int cb = (d0 * 16 + hi * 8) * 2;
                const bf16x8 b0 = *(const LAS bf16x8*)(Kb + KSWZ(r32, cb)); const bf16x8 b1 = *(const LAS bf16x8*)(Kb + KSWZ(32 + r32, cb));
                const bf16x8 qf = *(const LAS bf16x8*)(Ql + d0 * 1024);
                p0 = __builtin_amdgcn_mfma_f32_32x32x16_bf16(b0, qf, p0, 0, 0, 0); p1 = __builtin_amdgcn_mfma_f32_32x32x16_bf16(b1, qf, p1, 0, 0, 0);
                if (d0 & 1) SBAR(); }
            if (k0 + 64 > qw0) { sb_block<true>(p1, carry, k0 + 32, qpos, hi); SBAR(); sb_block<true>(p0, carry, k0, qpos, hi); }
            else { sb_block<false>(p1, carry, k0 + 32, qpos, hi); SBAR(); sb_block<false>(p0, carry, k0, qpos, hi); }
            SBAR();
            const u32x4 w0 = PK8(p0, 0), w1 = PK8(p0, 8), w2 = PK8(p1, 0), w3 = PK8(p1, 8);
            const bf16x8 pa0 = __builtin_bit_cast(bf16x8, w0), pa1 = __builtin_bit_cast(bf16x8, w1), pa2 = __builtin_bit_cast(bf16x8, w2), pa3 = __builtin_bit_cast(bf16x8, w3);
            const unsigned vb = vb0 + bb * TILE_B;
            pv_one<0>(o[0], vb, pa0, pa1, pa2, pa3); pv_one<1>(o[1], vb, pa0, pa1, pa2, pa3); pv_one<2>(o[2], vb, pa0, pa1, pa2, pa3); pv_one<3>(o[3], vb, pa0, pa1, pa2, pa3);
            wdone = __all(carry > SB_THRESH) != 0;
        }
        if (lane == 0) flags[bb * 8 + wid] = wdone ? 1u : 0u;
        asm volatile("s_waitcnt vmcnt(0)" ::: "memory"); __syncthreads();
        unsigned all = 1u;
#pragma unroll
        for (int w = 0; w < 8; ++w) all &= flags[bb * 8 + w];
        if (all) break;
    }
    bf16_t* Ow = O + (rowbase + qw0) * DA + h * HD;
#pragma unroll
    for (int r = 0; r < 16; ++r) { const int orow = crow(r, hi);
#pragma unroll
        for (int d0 = 0; d0 < 4; ++d0) Ow[(size_t)orow * DA + d0 * 32 + r32] = (bf16_t)(cvtpk(o[d0][r], 0.f) & 0xffffu); }
    __syncthreads();
#undef SLOAD
}

__device__ __forceinline__ void sample_unit(int b, int h, const bf16_t* Q, const bf16_t* Kn, const bf16_t* Vn, const float* cK, const float* cV, bf16_t* O, LAS unsigned char* lds) {
    const int tid = threadIdx.x, lane = tid & 63, r32 = lane & 31, hi = lane >> 5; const int wid = __builtin_amdgcn_readfirstlane(tid >> 6);
    const size_t row0 = (size_t)MP + (size_t)b * DECS;
    LAS float* rtab = (LAS float*)(lds + L_RTAB);
    f32x16 o[4]; o[0] = f32x16{}; o[1] = f32x16{}; o[2] = f32x16{}; o[3] = f32x16{};
    float carry = 0.f;
    constexpr int NTILE = PAST / 32 + 1;
    for (int rnd = 0; rnd * 8 < NTILE; ++rnd) {
        const int j = rnd * 8 + wid; const bool valid = j < NTILE; const int par = rnd & 1;
        f32x16 p = f32x16{}; float sp[16], Gp[4], T[4]; float tot = 0.f;
        if (valid) {
            const bf16_t* Qw = Q + (row0 + (r32 & 15)) * DA + h * HD + hi * 8;
            if (j == 0) {
                const bf16_t* Kw = Kn + (row0 + (r32 & 15)) * DA + h * HD + hi * 8;
#pragma unroll
                for (int d0 = 0; d0 < 8; ++d0) { bf16x8 kf = *(const bf16x8*)(Kw + d0 * 16), qf = *(const bf16x8*)(Qw + d0 * 16);
                    if (r32 >= DECS) { kf = (bf16x8){0, 0, 0, 0, 0, 0, 0, 0}; qf = kf; }
                    p = __builtin_amdgcn_mfma_f32_32x32x16_bf16(kf, qf, p, 0, 0, 0); }
                tot = sb_part1<true>(p, sp, Gp, T, hi, r32);
            } else {
                const float* Ku = cK + (((size_t)b * PAST + (PAST - 32 * j)) * NH + h) * HD;
                const int klo = r32 * NH * HD + hi * 8;
#pragma unroll
                for (int d0 = 0; d0 < 8; ++d0) { const f32x4 a = *(const f32x4*)(Ku + d0 * 16 + klo), c = *(const f32x4*)(Ku + d0 * 16 + 4 + klo);
                    const u32x4 w = {cvtpk(a[0], a[1]), cvtpk(a[2], a[3]), cvtpk(c[0], c[1]), cvtpk(c[2], c[3])};
                    bf16x8 qf = *(const bf16x8*)(Qw + d0 * 16); if (r32 >= DECS) qf = (bf16x8){0, 0, 0, 0, 0, 0, 0, 0};
                    p = __builtin_amdgcn_mfma_f32_32x32x16_bf16(__builtin_bit_cast(bf16x8, w), qf, p, 0, 0, 0);
                    if ((d0 & 3) == 3) asm volatile("" ::: "memory"); }
                tot = sb_part1<false>(p, sp, Gp, T, hi, r32);
            }
        }
        if (hi == 0) rtab[(par * 8 + wid) * 32 + r32] = tot;
        __syncthreads();
        float cin = carry, total = 0.f;
#pragma unroll
        for (int w = 0; w < 8; ++w) { const float x = rtab[(par * 8 + w) * 32 + r32]; if (w < wid) cin += x; total += x; }
        if (valid) {
            sb_part2(p, sp, Gp, T, cin);
            const u32x4 w0 = PK8(p, 0), w1 = PK8(p, 8);
            const bf16x8 pa0 = __builtin_bit_cast(bf16x8, w0), pa1 = __builtin_bit_cast(bf16x8, w1);
            if (j == 0) {
#pragma unroll
                for (int d0 = 0; d0 < 4; ++d0) { bf16x8 f;
#pragma unroll
                    for (int e = 0; e < 8; ++e) f[e] = (short)Vn[(row0 + 4 * hi + (e & 3) + 8 * (e >> 2)) * DA + h * HD + d0 * 32 + r32];
                    o[d0] = __builtin_amdgcn_mfma_f32_32x32x16_bf16(pa0, f, o[d0], 0, 0, 0); }
            } else {
                const float* Vu = cV + (((size_t)b * PAST + (PAST - 32 * j)) * NH + h) * HD;
                const int vlo = 4 * hi * NH * HD + r32;
#pragma unroll
                for (int d0 = 0; d0 < 4; ++d0) {
                    float x[16];
#pragma unroll
                    for (int e = 0; e < 16; ++e) x[e] = (Vu + ((16 * (e >> 3) + (e & 3) + 8 * ((e >> 2) & 1)) * NH * HD + d0 * 32))[vlo];
                    const u32x4 wa = {cvtpk(x[0], x[1]), cvtpk(x[2], x[3]), cvtpk(x[4], x[5]), cvtpk(x[6], x[7])}, wb = {cvtpk(x[8], x[9]), cvtpk(x[10], x[11]), cvtpk(x[12], x[13]), cvtpk(x[14], x[15])};
                    o[d0] = __builtin_amdgcn_mfma_f32_32x32x16_bf16(pa0, __builtin_bit_cast(bf16x8, wa), o[d0], 0, 0, 0);
                    o[d0] = __builtin_amdgcn_mfma_f32_32x32x16_bf16(pa1, __builtin_bit_cast(bf16x8, wb), o[d0], 0, 0, 0);
                    asm volatile("" ::: "memory");
                }
            }
        }
        carry += total;
        if (__all(r32 >= DECS || carry > SB_THRESH)) break;
    }
    LAS float* obuf = (LAS float*)(lds + L_OBUF);
#pragma unroll
    for (int r = 0; r < 8; ++r) { const int q = crow(r, hi);
#pragma unroll
        for (int d0 = 0; d0 < 4; ++d0) obuf[(wid * 16 + q) * 128 + d0 * 32 + r32] = o[d0][r]; }
    __syncthreads();
    { const int q = tid >> 5, d = (tid & 31) * 4; f32x4 s = {0.f, 0.f, 0.f, 0.f};
#pragma unroll
      for (int w = 0; w < 8; ++w) s += *(const LAS f32x4*)(obuf + (w * 16 + q) * 128 + d);
      u32x2 w2; w2.x = cvtpk(s[0], s[1]); w2.y = cvtpk(s[2], s[3]);
      *(u32x2*)(O + (row0 + q) * DA + h * HD + d) = w2; }
    __syncthreads();
}
#undef SBAR
#undef PK8
}

constexpr int NWAVES = 8;
constexpr int N_LAUNCHES = MK_N_LAUNCHES;
constexpr int NPHASE = 13;
constexpr int RING_OFF = 0, RING_BYTES = 131072;
constexpr int LDSCTL_OFF = RING_BYTES, MISC_OFF = LDSCTL_OFF + 320;
constexpr int LDS_BYTES = 147456;

#define GAS __attribute__((address_space(1)))
typedef unsigned short bf16;
typedef unsigned v4u __attribute__((ext_vector_type(4)));
typedef float f32x4 __attribute__((ext_vector_type(4)));
typedef GAS unsigned gu32;
#define RLX_AGENT __ATOMIC_RELAXED, __HIP_MEMORY_SCOPE_AGENT
#define LDS_WAIT() asm volatile("s_waitcnt lgkmcnt(0)" ::: "memory")
#define VM_WAIT() asm volatile("s_waitcnt vmcnt(0)" ::: "memory")
__device__ __forceinline__ unsigned f2bf(float f) { unsigned u = __builtin_bit_cast(unsigned, f); return (u + 0x7fffu + ((u >> 16) & 1u)) >> 16; }
__device__ __forceinline__ unsigned pk2(float lo, float hi) { return f2bf(lo) | (f2bf(hi) << 16); }

#define XB_TMO      128
#define XB_XCNT(j)  (256  + 64 * (j))
#define XB_XSUB(j)  (1280 + 64 * (j))
#define XB_XGEN(j)  (2304 + 64 * (j))
#define XB_TOP      3328
#define XB_TOPGEN   3392
#define XCD_BAR_WORDS 3456
#define XB_SPIN_CAP (1u << 18)
__device__ __forceinline__ unsigned xb_ld(unsigned* p)              { return __hip_atomic_load(p, __ATOMIC_RELAXED, __HIP_MEMORY_SCOPE_AGENT); }
__device__ __forceinline__ unsigned xb_add(unsigned* p, unsigned v) { return __hip_atomic_fetch_add(p, v, __ATOMIC_RELAXED, __HIP_MEMORY_SCOPE_AGENT); }
__device__ __forceinline__ unsigned xb_xcc_id() { return (unsigned)__builtin_amdgcn_s_getreg((3 << 11) | 20) & 0xFu; }
#define XB_SPIN(cond, bar) do { unsigned _sp = 0; while (cond) { __builtin_amdgcn_s_sleep(1); \
    if ((++_sp & 255u) == 0u) { if (xb_ld(&(bar)[XB_TMO])) break; if (_sp > XB_SPIN_CAP) { atomicAdd(&(bar)[XB_TMO], 1u); break; } } } } while (0)
struct XcdBarrier { unsigned* bar; unsigned x; volatile LAS unsigned* st; };
__device__ __forceinline__ XcdBarrier xcd_barrier_post(unsigned* bar, volatile LAS unsigned* st) {
    XcdBarrier b; b.bar = bar; b.x = xb_xcc_id(); b.st = st;
    if (threadIdx.x == 0) (void)xb_add(&bar[XB_XCNT(b.x)], 1u);
    return b;
}
__device__ __forceinline__ void xcd_barrier_complete(unsigned* bar, unsigned x, unsigned& nloc, unsigned& nx) {
    const unsigned G = gridDim.x * gridDim.y * gridDim.z;
    unsigned sum, cnt, mine, sp = 0u;
    for (;;) {
        sum = 0u; cnt = 0u; mine = 0u;
#pragma unroll
        for (unsigned j = 0; j < 16; ++j) { const unsigned c = xb_ld(&bar[XB_XCNT(j)]); sum += c; cnt += (c > 0u) ? 1u : 0u; mine = (j == x) ? c : mine; }
        if (sum == G) break;
        __builtin_amdgcn_s_sleep(1);
        if ((++sp & 255u) == 0u) { if (xb_ld(&bar[XB_TMO])) break; if (sp > XB_SPIN_CAP) { atomicAdd(&bar[XB_TMO], 1u); break; } }
    }
    nloc = mine > 0u ? mine : 1u; nx = cnt > 0u ? cnt : 1u;
}
__device__ __forceinline__ void xcd_barrier(const XcdBarrier& b) {
    asm volatile("s_waitcnt vmcnt(0)" ::: "memory");
    __syncthreads();
    if (threadIdx.x == 0) {
        unsigned* bar = b.bar;
        __builtin_amdgcn_s_waitcnt(0);
        unsigned nloc = b.st[0], nx = b.st[1];
        if (nloc == 0u) { xcd_barrier_complete(bar, b.x, nloc, nx); b.st[0] = nloc; b.st[1] = nx; }
        const unsigned old = xb_add(&bar[XB_XSUB(b.x)], 1u);
        const unsigned gen = old / nloc;
        if (old + 1u == (gen + 1u) * nloc) {
            __builtin_amdgcn_fence(__ATOMIC_RELEASE, "agent");
            asm volatile("s_waitcnt vmcnt(0)" ::: "memory");
            const unsigned og = xb_add(&bar[XB_TOP], 1u);
            const unsigned tg = og / nx;
            if (og + 1u == (tg + 1u) * nx) xb_add(&bar[XB_TOPGEN], 1u);
            else XB_SPIN(xb_ld(&bar[XB_TOPGEN]) == tg, bar);
            __builtin_amdgcn_fence(__ATOMIC_ACQUIRE, "agent");
            xb_add(&bar[XB_XGEN(b.x)], 1u);
            asm volatile("s_waitcnt vmcnt(0)" ::: "memory");
        } else {
            XB_SPIN(xb_ld(&bar[XB_XGEN(b.x)]) == gen, bar);
            __builtin_amdgcn_fence(__ATOMIC_ACQUIRE, "agent");
            asm volatile("s_waitcnt vmcnt(0)" ::: "memory");
        }
    }
    __syncthreads();
}

__device__ __forceinline__ float wave_sum(float v) {
#pragma unroll
    for (int o = 1; o < 64; o <<= 1) v += __shfl_xor(v, o);
    return v;
}
__device__ __forceinline__ int map_row(int mode, int n0) {
    if (mode == 1) { const bool up = n0 >= DFF; const int f = up ? n0 - DFF : n0; return (f >> 7) * 256 + (up ? 128 : 0) + (f & 127); }
    if (mode == 2) { if (n0 >= DC && n0 < 3 * DC) { const bool x = n0 >= 2 * DC; const int c = x ? n0 - 2 * DC : n0 - DC; return DC + (c >> 7) * 256 + (x ? 128 : 0) + (c & 127); } return n0; }
    return n0;
}
__device__ __forceinline__ void p0_transpose_item(const float* W, int K, int N, bf16* WT, int mode, LAS float* scr, int item, int lane) {
    const int nblk = N / 32, kb = item / nblk, nb = item % nblk, k0 = 64 * kb, n0 = 32 * nb; const int orow0 = map_row(mode, n0);
#pragma unroll 8
    for (int i = 0; i < 32; ++i) { const int kk = 2 * i + (lane >> 5); scr[kk * 33 + (lane & 31)] = W[(size_t)(k0 + kk) * N + n0 + (lane & 31)]; }
    LDS_WAIT(); asm volatile("" ::: "memory");
    const int c = lane & 7;
#pragma unroll
    for (int j = 0; j < 4; ++j) { const int n = (lane >> 3) + 8 * j; const LAS float* s = scr + (8 * c) * 33 + n;
        v4u o; o.x = pk2(s[0 * 33], s[1 * 33]); o.y = pk2(s[2 * 33], s[3 * 33]); o.z = pk2(s[4 * 33], s[5 * 33]); o.w = pk2(s[6 * 33], s[7 * 33]);
        *(GAS v4u*)(WT + (size_t)(orow0 + n) * K + k0 + 8 * c) = o; }
    LDS_WAIT(); asm volatile("" ::: "memory");
}
template <bool OUT_F32, int NSL> __device__ __forceinline__ void rms_row(const float* xrow, const float* g, void* orow, int lane, const float* prow = nullptr, float pscale = 0.f, float* xout = nullptr) {
    const f32x4* xr = (const f32x4*)xrow + lane; const f32x4* gr = (const f32x4*)g + lane;
    f32x4 v[8]; float s = 0.f;
#pragma unroll
    for (int j = 0; j < 8; ++j) { v[j] = xr[64 * j];
        if (NSL > 0) { f32x4 a = {0.f, 0.f, 0.f, 0.f};
#pragma unroll 2
            for (int sl = 0; sl < NSL; ++sl) a += ((const f32x4*)(prow + (size_t)sl * 256 * DM) + lane)[64 * j];
            v[j] += a * pscale; if (xout) ((f32x4*)xout + lane)[64 * j] = v[j]; }
        s += (v[j].x * v[j].x + v[j].y * v[j].y) + (v[j].z * v[j].z + v[j].w * v[j].w); }
    const float rstd = 1.0f / sqrtf(wave_sum(s) * (1.0f / DM) + EPS);
#pragma unroll
    for (int j = 0; j < 8; ++j) { const f32x4 gv = gr[64 * j]; const f32x4 y = v[j] * rstd * gv;
        if (OUT_F32) ((f32x4*)orow + lane)[64 * j] = y;
        else ((unsigned long long*)orow + lane)[64 * j] = (unsigned long long)pk2(y.x, y.y) | ((unsigned long long)pk2(y.z, y.w) << 32); }
}

template <bool OUT_F32, int NSL> __device__ __forceinline__ void rms_row_wg(const float* xrow, const float* g, void* orow, int lane, int wave, const float* prow, float pscale, float* xout, LAS float* red) {
    const int c4 = wave * 64 + lane;
    f32x4 v = ((const f32x4*)xrow)[c4]; f32x4 a = {0.f, 0.f, 0.f, 0.f};
#pragma unroll
    for (int sl = 0; sl < NSL; ++sl) a += ((const f32x4*)(prow + (size_t)sl * 256 * DM))[c4];
    v += a * pscale; if (xout) ((f32x4*)xout)[c4] = v;
    const float ss = wave_sum((v.x * v.x + v.y * v.y) + (v.z * v.z + v.w * v.w));
    if (lane == 0) red[wave] = ss;
    __syncthreads();
    float tot = 0.f;
#pragma unroll
    for (int w = 0; w < 8; ++w) tot += red[w];
    const float rstd = 1.0f / sqrtf(tot * (1.0f / DM) + EPS);
    const f32x4 gv = ((const f32x4*)g)[c4]; const f32x4 y = v * rstd * gv;
    if (OUT_F32) ((f32x4*)orow)[c4] = y;
    else ((unsigned long long*)orow)[c4] = (unsigned long long)pk2(y.x, y.y) | ((unsigned long long)pk2(y.z, y.w) << 32);
    __syncthreads();
}

struct Args { const float* in[18]; float* out; unsigned char* ws; int ph_lo, ph_hi, li, pad; };

__global__ void __launch_bounds__(NWAVES * 64, 2) mk_fwd(Args args) {
    extern __shared__ __attribute__((aligned(16))) unsigned char lds_raw[];
    LAS unsigned char* lds = (LAS unsigned char*)lds_raw;
    volatile LAS unsigned* MISC = (volatile LAS unsigned*)(lds + MISC_OFF);
    const int tid = threadIdx.x, lane = tid & 63, wave = __builtin_amdgcn_readfirstlane(tid >> 6);
    const int G = gridDim.x; const int bx = blockIdx.x; const int vcu = (G % 8 == 0) ? (bx % 8) * (G / 8) + bx / 8 : bx;
#define ws (args.ws)
    gu32* ctl = (gu32*)(ws + WS_CTL);
#define x_prompt (args.in[0])
#define x_sample (args.in[1])
#define cache_k (args.in[2])
#define cache_v (args.in[3])
#define state_conv (args.in[4])
#define g_ffn1 (args.in[5])
#define w_gu1 (args.in[6])
#define w_dn1 (args.in[7])
#define g_mix (args.in[8])
#define w_in (args.in[9])
#define conv_w (args.in[10])
#define w_co (args.in[11])
#define w_ao (args.in[12])
#define w_o (args.in[13])
#define g_ffn2 (args.in[14])
#define w_gu2 (args.in[15])
#define w_dn2 (args.in[16])
#define g_fin (args.in[17])
#define out (args.out)
#define Wgu1 ((bf16*)(ws + WS_WGU1))
#define Wdn1 ((bf16*)(ws + WS_WDN1))
#define Win ((bf16*)(ws + WS_WIN))
#define Wco ((bf16*)(ws + WS_WCO))
#define Wao ((bf16*)(ws + WS_WAO))
#define Wo ((bf16*)(ws + WS_WO))
#define Wgu2 ((bf16*)(ws + WS_WGU2))
#define Wdn2 ((bf16*)(ws + WS_WDN2))
#define XN ((bf16*)(ws + WS_XN))
#define XG ((bf16*)(ws + WS_XG))
#define ACT ((bf16*)(ws + WS_ACT))
#define X ((float*)(ws + WS_X))
#define T ((float*)(ws + WS_T))
#define CB ((bf16*)(ws + WS_CB))
#define U ((bf16*)(ws + WS_U))
#define Qb ((bf16*)(ws + WS_Q))
#define Kb ((bf16*)(ws + WS_K))
#define Vb ((bf16*)(ws + WS_V))
#define Ob ((bf16*)(ws + WS_O))
#define SA ((bf16*)(ws + WS_SA))
#define SBg ((bf16*)(ws + WS_SB))
#define MIXED ((bf16*)(ws + WS_MIXED))
#define PART ((float*)(ws + WS_PART))
    for (int u = tid; u < (LDS_BYTES - LDSCTL_OFF) / 4; u += NWAVES * 64) ((LAS unsigned*)(lds + LDSCTL_OFF))[u] = 0u;
    __syncthreads();
    XcdBarrier bar; bar.bar = (unsigned*)(ctl + CW_BAR); bar.x = 0; bar.st = nullptr;
    if (N_LAUNCHES == 1) bar = xcd_barrier_post((unsigned*)(ctl + CW_BAR), MISC + 8);
    const int lo = args.ph_lo, hi = args.ph_hi;
#ifndef PH_MASK
#define PH_MASK 0x1fff
#endif
#define IN(k) (((PH_MASK >> (k)) & 1) && lo <= (k) && (k) < hi)
#define SEAM(k) do { if (IN(k) && IN((k) + 1)) xcd_barrier(bar); } while (0)
    const int gw = vcu * NWAVES + wave, NGW = G * NWAVES;

    if (IN(0)) {
        LAS float* scr = (LAS float*)(lds + RING_OFF + wave * 16384);
        constexpr int I_GU = (DM / 64) * (2 * DFF / 32), I_DN = (DFF / 64) * (DM / 32), I_IN = (DM / 64) * (DIN / 32), I_CO = (DC / 64) * (DM / 32), I_AO = (DA / 64) * (DM / 32), I_WO = (DM / 64) * (DM / 32);
        constexpr int NITEMS = 2 * I_GU + 2 * I_DN + I_IN + I_CO + I_AO + I_WO;
        for (int it = gw; it < NITEMS; it += NGW) {
            int r = it;
            if (r < I_GU) { p0_transpose_item(w_gu1, DM, 2 * DFF, Wgu1, 1, scr, r, lane); continue; } r -= I_GU;
            if (r < I_DN) { p0_transpose_item(w_dn1, DFF, DM, Wdn1, 0, scr, r, lane); continue; } r -= I_DN;
            if (r < I_IN) { p0_transpose_item(w_in, DM, DIN, Win, 2, scr, r, lane); continue; } r -= I_IN;
            if (r < I_CO) { p0_transpose_item(w_co, DC, DM, Wco, 0, scr, r, lane); continue; } r -= I_CO;
            if (r < I_AO) { p0_transpose_item(w_ao, DA, DM, Wao, 0, scr, r, lane); continue; } r -= I_AO;
            if (r < I_WO) { p0_transpose_item(w_o, DM, DM, Wo, 0, scr, r, lane); continue; } r -= I_WO;
            if (r < I_GU) { p0_transpose_item(w_gu2, DM, 2 * DFF, Wgu2, 1, scr, r, lane); continue; } r -= I_GU;
            p0_transpose_item(w_dn2, DFF, DM, Wdn2, 0, scr, r, lane);
        }
        for (int m = gw; m < M; m += NGW) { const float* xr = (m < MP) ? x_prompt + (size_t)m * DM : x_sample + (size_t)(m - MP) * DM; rms_row<false, 0>(xr, g_ffn1, XN + (size_t)m * DM, lane); }
    }
    SEAM(0);
    if (IN(1)) { pg8::Gemm g{XN, Wgu1, M, 2 * DFF, DM}; pg8::StaticOrder S; S.init(M, 2 * DFF, G, bx, DM); pg8::EpiGU E{ACT};
        pg8::gemm_phase<pg8::EpiGU, pg8::StaticOrder, true, true>(lds + RING_OFF, g, S, E); }
    SEAM(1);
    if (IN(2)) { pg8::Gemm g{ACT, Wdn1, M, DM, DFF}; pg8::SkOrder S; S.init(G, bx, DFF, 4); pg8::EpiDN E{x_prompt, x_sample, X, 0.5f, PART};
        pg8::gemm_phase<pg8::EpiDN, pg8::SkOrder, true, true>(lds + RING_OFF, g, S, E); }
    SEAM(2);
    if (IN(3)) {
        for (int r = vcu; r < MS; r += G) rms_row_wg<false, 22>(x_sample + (size_t)r * DM, g_mix, XG + (size_t)(MP + r) * DM, lane, wave, PART + (size_t)r * DM, 0.5f, X + (size_t)(MP + r) * DM, (LAS float*)(lds + LDSCTL_OFF + 4096));
        for (int m = gw; m < MP; m += NGW) rms_row<false, 0>(X + (size_t)m * DM, g_mix, XG + (size_t)m * DM, lane);
    }
    SEAM(3);
    if (IN(4)) { pg8::Gemm g{XG, Win, M, DIN, DM}; pg8::StaticOrder S; S.init(M, DIN, G, bx, DM); pg8::EpiIN E{CB, U, Qb, Kb, Vb, SA, SBg, out};
        pg8::gemm_phase<pg8::EpiIN, pg8::StaticOrder, true, true>(lds + RING_OFF, g, S, E); }
    SEAM(4);
    if (IN(5)) {
#if !defined(P5_OFF_A)
        for (int u = vcu; u < NB * NH * (SEQ / 256); u += G) { const int bh = u >> 3, qb = u & 7; sba::prompt_unit(bh / NH, bh % NH, qb, Qb, Kb, Vb, Ob, lds + RING_OFF); }
#endif
#if !defined(P5_OFF_B)
        for (int u = vcu; u < DECB * NH; u += G) { const int uu = (u * 2) % (DECB * NH) + (u * 2) / (DECB * NH);
            sba::sample_unit(uu / NH, uu % NH, Qb, Kb, Vb, cache_k, cache_v, Ob, lds + RING_OFF); }
#endif
        for (int it = vcu; it < M / 4; it += G) {
            const int m = 4 * it + (tid >> 7), cg = (tid & 127) * 8;
            const int t = (m < MP) ? (m % SEQ) : ((m - MP) % DECS);
            float u0[8], u1[8], u2[8];
            { const v4u w = *(const v4u*)(U + (size_t)m * DC + cg); u0[0] = pg8::bf_lo(w.x); u0[1] = pg8::bf_hi(w.x); u0[2] = pg8::bf_lo(w.y); u0[3] = pg8::bf_hi(w.y); u0[4] = pg8::bf_lo(w.z); u0[5] = pg8::bf_hi(w.z); u0[6] = pg8::bf_lo(w.w); u0[7] = pg8::bf_hi(w.w); }
            if (t >= 1) { const v4u w = *(const v4u*)(U + (size_t)(m - 1) * DC + cg); u1[0] = pg8::bf_lo(w.x); u1[1] = pg8::bf_hi(w.x); u1[2] = pg8::bf_lo(w.y); u1[3] = pg8::bf_hi(w.y); u1[4] = pg8::bf_lo(w.z); u1[5] = pg8::bf_hi(w.z); u1[6] = pg8::bf_lo(w.w); u1[7] = pg8::bf_hi(w.w); }
            else if (m >= MP) { const float* s = state_conv + ((size_t)((m - MP) / DECS) * 2 + 1) * DC + cg; for (int e = 0; e < 8; ++e) u1[e] = s[e]; }
            else { for (int e = 0; e < 8; ++e) u1[e] = 0.f; }
            if (t >= 2) { const v4u w = *(const v4u*)(U + (size_t)(m - 2) * DC + cg); u2[0] = pg8::bf_lo(w.x); u2[1] = pg8::bf_hi(w.x); u2[2] = pg8::bf_lo(w.y); u2[3] = pg8::bf_hi(w.y); u2[4] = pg8::bf_lo(w.z); u2[5] = pg8::bf_hi(w.z); u2[6] = pg8::bf_lo(w.w); u2[7] = pg8::bf_hi(w.w); }
            else if (m >= MP) { const float* s = state_conv + ((size_t)((m - MP) / DECS) * 2 + t) * DC + cg; for (int e = 0; e < 8; ++e) u2[e] = s[e]; }
            else { for (int e = 0; e < 8; ++e) u2[e] = 0.f; }
            const v4u cw = *(const v4u*)(CB + (size_t)m * DC + cg);
            float c[8]; c[0] = pg8::bf_lo(cw.x); c[1] = pg8::bf_hi(cw.x); c[2] = pg8::bf_lo(cw.y); c[3] = pg8::bf_hi(cw.y); c[4] = pg8::bf_lo(cw.z); c[5] = pg8::bf_hi(cw.z); c[6] = pg8::bf_lo(cw.w); c[7] = pg8::bf_hi(cw.w);
            float r[8];
#pragma unroll
            for (int e = 0; e < 8; ++e) r[e] = c[e] * (conv_w[cg + e] * u2[e] + conv_w[DC + cg + e] * u1[e] + conv_w[2 * DC + cg + e] * u0[e]);
            v4u o; o.x = pk2(r[0], r[1]); o.y = pk2(r[2], r[3]); o.z = pk2(r[4], r[5]); o.w = pk2(r[6], r[7]);
            *(v4u*)(CB + (size_t)m * DC + cg) = o;
        }
    }
    SEAM(5);
    if (IN(6)) { pg8::Gemm g{CB, Wco, M, DM, DC}; pg8::StaticOrder S; S.init(M, DM, G, bx, DC); pg8::EpiCO E{SA, T};
        pg8::gemm_phase<pg8::EpiCO, pg8::StaticOrder, true, true>(lds + RING_OFF, g, S, E); }
    SEAM(6);
    if (IN(7)) { pg8::Gemm g{Ob, Wao, M, DM, DA}; pg8::StaticOrder S; S.init(M, DM, G, bx, DA); pg8::EpiAO E{SBg, T, MIXED};
        pg8::gemm_phase<pg8::EpiAO, pg8::StaticOrder, true, true>(lds + RING_OFF, g, S, E); }
    SEAM(7);
    if (IN(8)) { pg8::Gemm g{MIXED, Wo, M, DM, DM}; pg8::StaticOrder S; S.init(M, DM, G, bx, DM); pg8::EpiDN E{X, X + (size_t)MP * DM, X, 1.0f, nullptr};
        pg8::gemm_phase<pg8::EpiDN, pg8::StaticOrder, true, true>(lds + RING_OFF, g, S, E); }
    SEAM(8);
    if (IN(9)) { for (int m = gw; m < M; m += NGW) rms_row<false, 0>(X + (size_t)m * DM, g_ffn2, XG + (size_t)m * DM, lane); }
    SEAM(9);
    if (IN(10)) { pg8::Gemm g{XG, Wgu2, M, 2 * DFF, DM}; pg8::StaticOrder S; S.init(M, 2 * DFF, G, bx, DM); pg8::EpiGU E{ACT};
        pg8::gemm_phase<pg8::EpiGU, pg8::StaticOrder, true, true>(lds + RING_OFF, g, S, E); }
    SEAM(10);
    if (IN(11)) { pg8::Gemm g{ACT, Wdn2, M, DM, DFF}; pg8::SkOrder S; S.init(G, bx, DFF, 4); pg8::EpiDN E{X, X + (size_t)MP * DM, out + O_Y, 0.5f, PART};
        pg8::gemm_phase<pg8::EpiDN, pg8::SkOrder, true, true>(lds + RING_OFF, g, S, E); }
    SEAM(11);
    if (IN(12)) {
        for (int r = vcu; r < MS; r += G) rms_row_wg<true, 22>(X + (size_t)(MP + r) * DM, g_fin, out + O_Y + (size_t)(MP + r) * DM, lane, wave, PART + (size_t)r * DM, 0.5f, nullptr, (LAS float*)(lds + LDSCTL_OFF + 4096));
        for (int m = gw; m < MP; m += NGW) rms_row<true, 0>(out + O_Y + (size_t)m * DM, g_fin, out + O_Y + (size_t)m * DM, lane);
    }
#undef IN
#undef SEAM
}
#undef x_prompt
#undef x_sample
#undef cache_k
#undef cache_v
#undef state_conv
#undef g_ffn1
#undef w_gu1
#undef w_dn1
#undef g_mix
#undef w_in
#undef conv_w
#undef w_co
#undef w_ao
#undef w_o
#undef g_ffn2
#undef w_gu2
#undef w_dn2
#undef g_fin
#undef out
#undef Wgu1
#undef Wdn1
#undef Win
#undef Wco
#undef Wao
#undef Wo
#undef Wgu2
#undef Wdn2
#undef XN
#undef XG
#undef ACT
#undef X
#undef T
#undef CB
#undef U
#undef Qb
#undef Kb
#undef Vb
#undef Ob
#undef SA
#undef SBg
#undef MIXED
#undef PART
#undef ws

extern "C" void kernel_launch(void* const* d_in, const int* in_sizes, int n_in, void* d_out, int out_size, void* d_ws, size_t ws_size, hipStream_t stream) {
    static int grid = 0;
    if (grid == 0) {
        if (n_in != 18 || in_sizes[0] != MP * DM || (size_t)out_size != O_END || ws_size < WS_END) {
            fprintf(stderr, "kernel_launch: unexpected shapes: n_in %d in0 %d out %d ws %zu (need >= %zu); nothing launched\n", n_in, n_in > 0 ? in_sizes[0] : -1, out_size, ws_size, (size_t)WS_END); grid = -1; return; }
        int dev = 0, cus = 0, per_cu = 0;
        if (hipGetDevice(&dev) != hipSuccess || hipDeviceGetAttribute(&cus, hipDeviceAttributeMultiprocessorCount, dev) != hipSuccess) { grid = -1; return; }
        if (hipFuncSetAttribute((const void*)mk_fwd, hipFuncAttributeMaxDynamicSharedMemorySize, LDS_BYTES) != hipSuccess) { fprintf(stderr, "kernel_launch: hipFuncSetAttribute failed\n"); grid = -1; return; }
        if (hipOccupancyMaxActiveBlocksPerMultiprocessor(&per_cu, (const void*)mk_fwd, NWAVES * 64, LDS_BYTES) != hipSuccess || per_cu < 1) {
            fprintf(stderr, "kernel_launch: occupancy query reports %d workgroups per CU; nothing launched\n", per_cu); (void)hipGetLastError(); grid = -1; return; }
        (void)hipGetLastError();
        grid = cus;
    }
    if (grid < 0) return;
    if (hipMemsetAsync((char*)d_ws + WS_CTL, 0, CTL_ZERO_BYTES, stream) != hipSuccess) return;
    Args a{};
    for (int i = 0; i < 18; ++i) a.in[i] = (const float*)d_in[i];
    a.out = (float*)d_out; a.ws = (unsigned char*)d_ws;
    for (int li = 0; li < N_LAUNCHES; ++li) {
        if (N_LAUNCHES == 1) { a.ph_lo = 0; a.ph_hi = NPHASE; } else { a.ph_lo = li; a.ph_hi = li + 1; }
        a.li = li;
        hipLaunchKernelGGL(mk_fwd, dim3(grid), dim3(NWAVES * 64), LDS_BYTES, stream, a);
    }
}
```
